# Optimizing an MI355X kernel written in HIP

```python
import jax, jax.numpy as jnp
from jax import lax
import numpy as np

D_MODEL = 1024
BATCH = 16
SEQ = 2048
DEPTH = 1

LRU_WIDTH = D_MODEL
LRU_BLOCKS = 16
LRU_BW = LRU_WIDTH // LRU_BLOCKS
CONV_WIDTH = 4
LRU_C = 8.0
RET_HEADS = 4
RET_DK = 256
RET_DV = 256
RET_QK_WIDTH = RET_HEADS * RET_DK
RET_WIDTH = RET_HEADS * RET_DV
CHUNK = 128
ROPE_THETA = 10000.0
EPS = 1e-6
IN_SIZES = (LRU_WIDTH, LRU_WIDTH, RET_QK_WIDTH, RET_QK_WIDTH, RET_WIDTH, RET_WIDTH, D_MODEL, D_MODEL)
IN_COLS = sum(IN_SIZES)
SPLIT_POINTS = tuple(int(c) for c in np.cumsum(IN_SIZES)[:-1])

kernel_name = "hybrid_rglru_retention_gated_block"


def rmsnorm(x, g):
    xf = x.astype(jnp.float32)
    y = xf * lax.rsqrt(jnp.mean(xf * xf, axis=-1, keepdims=True) + EPS)
    return (y * g.astype(jnp.float32)).astype(x.dtype)


def causal_depthwise_conv(x, w, b):
    S = x.shape[1]
    xp = jnp.pad(x, ((0, 0), (CONV_WIDTH - 1, 0), (0, 0)))
    y = b
    for k in range(CONV_WIDTH):
        y = y + xp[:, k:k + S, :] * w[k]
    return y


def block_diag_linear(x, w, b):
    B, S, W = x.shape
    xb = x.reshape(B, S, LRU_BLOCKS, LRU_BW)
    return jnp.einsum('bsnk,nkj->bsnj', xb, w).reshape(B, S, W) + b


def rg_lru(x, wx, bx, wa, ba, lam):
    B, S, W = x.shape
    i_t = jax.nn.sigmoid(block_diag_linear(x, wx, bx))
    r_t = jax.nn.sigmoid(block_diag_linear(x, wa, ba))
    log_a = -LRU_C * r_t.astype(jnp.float32) * jax.nn.softplus(-lam.astype(jnp.float32))
    a = jnp.exp(log_a)
    mult = jnp.sqrt(-jnp.expm1(2.0 * log_a))
    u = mult * (i_t * x).astype(jnp.float32)

    def step(h, au):
        a_t, u_t = au
        h = a_t * h + u_t
        return h, h

    _, hs = lax.scan(step, jnp.zeros((B, W), jnp.float32),
                     (jnp.swapaxes(a, 0, 1), jnp.swapaxes(u, 0, 1)))
    return jnp.swapaxes(hs, 0, 1).astype(x.dtype)


def rotary(x):
    S, D = x.shape[1], x.shape[3]
    half = D // 2
    freqs = ROPE_THETA ** (-jnp.arange(half, dtype=jnp.float32) / half)
    ang = jnp.arange(S, dtype=jnp.float32)[:, None] * freqs[None, :]
    cos = jnp.cos(ang)[None, :, None, :]
    sin = jnp.sin(ang)[None, :, None, :]
    x1, x2 = x[..., :half], x[..., half:]
    return jnp.concatenate([x1 * cos - x2 * sin, x1 * sin + x2 * cos], axis=-1)


def retention_chunkwise(q, k, v):
    B, S, H, DK = q.shape
    DV = v.shape[-1]
    NC = S // CHUNK
    log_g = jnp.log1p(-(2.0 ** (-5.0 - jnp.arange(H, dtype=jnp.float32))))
    idx = jnp.arange(CHUNK, dtype=jnp.float32)
    diff = idx[:, None] - idx[None, :]
    inner_decay = jnp.where(diff >= 0, jnp.exp(jnp.maximum(diff, 0.0)[None] * log_g[:, None, None]), 0.0)
    cross_decay = jnp.exp((idx[:, None] + 1.0) * log_g[None, :])[None, :, :, None]
    state_decay = jnp.exp((CHUNK - 1.0 - idx[:, None]) * log_g[None, :])[None, :, :, None]
    chunk_decay = jnp.exp(CHUNK * log_g)[None, :, None, None]

    def to_chunks(t):
        return jnp.swapaxes(t.reshape(B, NC, CHUNK, H, t.shape[-1]), 0, 1)

    def step(R, qkv):
        qc, kc, vc = qkv
        scores = jnp.einsum('bihd,bjhd->bhij', qc, kc) * inner_decay
        inner = jnp.einsum('bhij,bjhe->bihe', scores, vc)
        cross = jnp.einsum('bihd,bhde->bihe', qc, R) * cross_decay
        R_new = chunk_decay * R + jnp.einsum('bjhd,bjhe->bhde', kc, vc * state_decay)
        return R_new, inner + cross

    R0 = jnp.zeros((B, H, DK, DV), jnp.float32)
    _, out = lax.scan(step, R0, (to_chunks(q), to_chunks(k), to_chunks(v)))
    return jnp.swapaxes(out, 0, 1).reshape(B, S, H, DV)


def head_groupnorm(y, g):
    mu = jnp.mean(y, axis=-1, keepdims=True)
    yc = y - mu
    var = jnp.mean(yc * yc, axis=-1, keepdims=True)
    return yc * lax.rsqrt(var + EPS) * g.astype(jnp.float32)


def setup_inputs(seed: int = 0) -> dict:
    key = jax.random.key(seed)
    ks = jax.random.split(key, 16)
    L = DEPTH
    f32 = jnp.float32
    nrm = lambda k, shape, fan: jax.random.normal(k, shape, f32) * (fan ** -0.5)
    a0 = jax.random.uniform(ks[10], (L, LRU_WIDTH), f32, 0.9, 0.999)
    return {
        "x": jax.random.normal(ks[0], (BATCH, SEQ, D_MODEL), f32),
        "norm_in": 1.0 + 0.02 * jax.random.normal(ks[1], (L, D_MODEL), f32),
        "w_in": nrm(ks[2], (L, D_MODEL, IN_COLS), D_MODEL),
        "conv_w": nrm(ks[3], (L, CONV_WIDTH, LRU_WIDTH), CONV_WIDTH),
        "conv_b": 0.02 * jax.random.normal(ks[4], (L, LRU_WIDTH), f32),
        "gate_x_w": nrm(ks[5], (L, LRU_BLOCKS, LRU_BW, LRU_BW), LRU_BW),
        "gate_x_b": 0.02 * jax.random.normal(ks[6], (L, LRU_WIDTH), f32),
        "gate_a_w": nrm(ks[7], (L, LRU_BLOCKS, LRU_BW, LRU_BW), LRU_BW),
        "gate_a_b": 0.02 * jax.random.normal(ks[8], (L, LRU_WIDTH), f32),
        "lru_lambda": jnp.log(a0 / (1.0 - a0)),
        "gn_gain": 1.0 + 0.02 * jax.random.normal(ks[9], (L, RET_HEADS, RET_DV), f32),
        "w_proj_a": nrm(ks[11], (L, LRU_WIDTH, D_MODEL), LRU_WIDTH),
        "w_proj_b": nrm(ks[12], (L, RET_WIDTH, D_MODEL), RET_WIDTH),
        "w_out": nrm(ks[13], (L, D_MODEL, D_MODEL), D_MODEL),
        "norm_final": 1.0 + 0.02 * jax.random.normal(ks[14], (D_MODEL,), f32),
    }


def reference(x, norm_in, w_in, conv_w, conv_b, gate_x_w, gate_x_b, gate_a_w, gate_a_b,
              lru_lambda, gn_gain, w_proj_a, w_proj_b, w_out, norm_final):
    B, S, _ = x.shape
    for l in range(DEPTH):
        h = rmsnorm(x, norm_in[l])
        proj = jnp.einsum('bsd,dc->bsc', h, w_in[l])
        xa, ga, q, k, v, gb, ma, mb = jnp.split(proj, SPLIT_POINTS, axis=-1)

        xa = causal_depthwise_conv(xa, conv_w[l], conv_b[l])
        ya = rg_lru(xa, gate_x_w[l], gate_x_b[l], gate_a_w[l], gate_a_b[l], lru_lambda[l])
        ya = jax.nn.silu(ga) * ya
        out_a = jnp.einsum('bsw,wd->bsd', ya, w_proj_a[l])

        qh = rotary(q.reshape(B, S, RET_HEADS, RET_DK).astype(jnp.float32))
        kh = rotary(k.reshape(B, S, RET_HEADS, RET_DK).astype(jnp.float32)) * (RET_DK ** -0.5)
        vh = v.reshape(B, S, RET_HEADS, RET_DV).astype(jnp.float32)
        ret = head_groupnorm(retention_chunkwise(qh, kh, vh), gn_gain[l])
        yb = jax.nn.silu(gb) * ret.reshape(B, S, RET_WIDTH).astype(x.dtype)
        out_b = jnp.einsum('bsw,wd->bsd', yb, w_proj_b[l])

        merged = jax.nn.sigmoid(ma) * out_a + jax.nn.sigmoid(mb) * out_b
        x = x + jnp.einsum('bsd,de->bse', merged, w_out[l])
    return rmsnorm(x, norm_final)
```

```cpp
#include <hip/hip_runtime.h>
#include <hip/hip_cooperative_groups.h>
#include <cstdio>
#include <cstdint>
namespace cg = cooperative_groups;
namespace pg8 {
#define PG8_LAS __attribute__((address_space(3)))
typedef unsigned short bf16_t;
typedef short bf16x8 __attribute__((ext_vector_type(8)));
typedef float f32x4 __attribute__((ext_vector_type(4)));
typedef unsigned u32x4 __attribute__((ext_vector_type(4)));
constexpr int BM = 256, BK = 64, HALF = 128, HTB = HALF * BK * 2  , STAGE_BYTES = 8 * HTB, NXCD = 8, WGM = 8;

__host__ __device__ __forceinline__ int lds_byte(int r, int c) { const int st = (r >> 4) * 2 + (c >> 5), rr = r & 15, cc = c & 31, ob = rr * 64 + cc * 2; return st * 1024 + (ob ^ (((ob >> 9) & 1) << 5)); }
__host__ __device__ __forceinline__ void stage_rc(int b, int& R, int& C) { const int st = b / 1024, sb = b % 1024, swz = sb ^ (((sb >> 9) & 1) << 5); R = (st >> 1) * 16 + swz / 64; C = (st & 1) * 32 + (swz % 64) / 2; }
__host__ __device__ __forceinline__ int perm32(int rho) { const int n = rho >> 4, i = rho & 15; return 8 * (i >> 2) + 4 * n + (i & 3); }

struct Unit { int pm, pn; };
struct Gemm { const bf16_t* A; const bf16_t* Bt; int M, N, K; };

struct StaticOrder {
    int nM, nN, nwg, G, c;
    __host__ __device__ void init(int M, int N, int G_, int c_) { nM = M / BM; nN = N / BM; nwg = nM * nN; G = G_; c = c_; }
    __host__ __device__ bool next(int i, Unit& u) const {
        const long L = (long)i * G + c; if (L >= nwg) return false;
        int wgid = (int)L; { const int q = nwg / NXCD, r = nwg % NXCD, xcd = wgid % NXCD, off = wgid / NXCD; wgid = (xcd < r ? xcd * (q + 1) : r * (q + 1) + (xcd - r) * q) + off; }
        const int nig = WGM * nN, gid = wgid / nig, fm = gid * WGM, gsz = (nM - fm) < WGM ? (nM - fm) : WGM;
        u.pm = fm + ((wgid % nig) % gsz); u.pn = (wgid % nig) / gsz; return true;
    }
    __device__ __forceinline__ void a_ready(const Unit&) const {}
    __device__ __forceinline__ void done(const Unit&) const {}
};
typedef __bf16 bf16x2_cv __attribute__((ext_vector_type(2)));
typedef float f32x2_cv __attribute__((ext_vector_type(2)));
__device__ __forceinline__ unsigned cvt_pk_bf16(float lo, float hi) { const f32x2_cv v = {lo, hi}; return __builtin_bit_cast(unsigned, __builtin_convertvector(v, bf16x2_cv)); }
template <class Epi, class Sched, bool ALIGN_EPI = false, bool SP2 = false>
__device__ __forceinline__ void gemm_phase(PG8_LAS unsigned char* lds, const Gemm g, const Sched& S, const Epi& E) {
    const int tid = threadIdx.x, wid = __builtin_amdgcn_readfirstlane(tid >> 6), lane = tid & 63, wr = wid >> 2, wc = wid & 3, fr = lane & 15, fq = lane >> 4;
    const int K = g.K, nt = K / BK;
    unsigned voffA[2], voffB[2];
#pragma unroll
    for (int i = 0; i < 2; ++i) { int R, C; stage_rc(tid * 16 + i * 8192, R, C); const int Rb = Epi::PERM ? ((R & ~31) + perm32(R & 31)) : R;
        voffA[i] = (unsigned)(R * K + C) * 2u; voffB[i] = (unsigned)(Rb * K + C) * 2u; }
    const size_t kstep = (size_t)(BK * 2);
    const size_t hstep = (size_t)HALF * K * 2;
    const size_t tstep = 2 * hstep;
    const unsigned ldsw = (unsigned)wid * 1024u;
    const int aoff = lds_byte(wr * 64 + fr, fq * 8), boff = lds_byte(wc * 32 + fr, fq * 8);
#define PG8_SA(b, h) (((b) * 2 + (h)) * HTB)
#define PG8_SB(b, h) ((4 + (b) * 2 + (h)) * HTB)
#define PG8_STAGE(bufoff, gbase, voff) do { _Pragma("unroll") for (int _i = 0; _i < 2; ++_i) \
        __builtin_amdgcn_global_load_lds((const unsigned*)((const char*)(gbase) + (voff)[_i]), (PG8_LAS unsigned*)(lds + (bufoff) + ldsw + _i * 8192), 16, 0, 0); } while (0)
#define PG8_LDA(dst, b, h) do { _Pragma("unroll") for (int m = 0; m < 4; ++m) _Pragma("unroll") for (int k = 0; k < 2; ++k) dst[m][k] = *(const PG8_LAS bf16x8*)(lds + PG8_SA(b, h) + aoff + m * 2048 + k * 1024); } while (0)
#define PG8_LDB(dst, b, h) do { _Pragma("unroll") for (int n = 0; n < 2; ++n) _Pragma("unroll") for (int k = 0; k < 2; ++k) dst[n][k] = *(const PG8_LAS bf16x8*)(lds + PG8_SB(b, h) + boff + n * 2048 + k * 1024); } while (0)
#define PG8_MMA(ai, bj, At, Bt) do { __builtin_amdgcn_s_setprio(1); _Pragma("unroll") for (int m = 0; m < 4; ++m) _Pragma("unroll") for (int n = 0; n < 2; ++n) _Pragma("unroll") for (int k = 0; k < 2; ++k) \
        acc[ai][bj][m][n] = __builtin_amdgcn_mfma_f32_16x16x32_bf16(Bt[n][k], At[m][k], acc[ai][bj][m][n], 0, 0, 0); __builtin_amdgcn_s_setprio(0); } while (0)
#define PG8_WAIT_V(n) asm volatile("s_waitcnt vmcnt(" #n ")" ::: "memory")
#define PG8_WAIT_L(n) asm volatile("s_waitcnt lgkmcnt(" #n ")" ::: "memory")
#define PG8_BAR __builtin_amdgcn_s_barrier()
#define PG8_SCHED __builtin_amdgcn_sched_barrier(0)
    Unit cur, nxt; int ui = 0;
    if (!S.next(0, cur)) return;
    f32x4 acc[2][2][4][2];
#pragma unroll
    for (int a = 0; a < 2; ++a)
#pragma unroll
        for (int b = 0; b < 2; ++b)
#pragma unroll
            for (int m = 0; m < 4; ++m)
#pragma unroll
                for (int n = 0; n < 2; ++n) acc[a][b][m][n] = (f32x4){0.f, 0.f, 0.f, 0.f};
    bf16x8 At[4][2], B0[2][2], B1[2][2];
    const char* cA = (const char*)g.A + (size_t)cur.pm * tstep; const char* cB = (const char*)g.Bt + (size_t)cur.pn * tstep;
    S.a_ready(cur);
    if constexpr (SP2) {
        PG8_STAGE(PG8_SB(0, 0), cB, voffB); PG8_STAGE(PG8_SB(0, 1), cB + hstep, voffB); PG8_STAGE(PG8_SA(0, 0), cA, voffA); PG8_STAGE(PG8_SA(0, 1), cA + hstep, voffA);
        if (wr == 1) PG8_BAR;
        PG8_WAIT_V(2); PG8_BAR;
        PG8_STAGE(PG8_SB(1, 0), cB + kstep, voffB); PG8_STAGE(PG8_SA(1, 0), cA + kstep, voffA); PG8_STAGE(PG8_SB(1, 1), cB + hstep + kstep, voffB);
        PG8_WAIT_V(6); PG8_BAR;
    } else {
        PG8_STAGE(PG8_SB(0, 0), cB, voffB); PG8_STAGE(PG8_SA(0, 0), cA, voffA); PG8_STAGE(PG8_SB(0, 1), cB + hstep, voffB); PG8_STAGE(PG8_SA(0, 1), cA + hstep, voffA);
        if (wr == 1) PG8_BAR;
        PG8_WAIT_V(4); PG8_BAR;
        PG8_STAGE(PG8_SB(1, 0), cB + kstep, voffB); PG8_STAGE(PG8_SA(1, 0), cA + kstep, voffA); PG8_STAGE(PG8_SB(1, 1), cB + hstep + kstep, voffB);
        PG8_WAIT_V(6); PG8_BAR;
    }
    for (;;) {
        const bool has_next = S.next(ui + 1, nxt);
        const char* nA = has_next ? (const char*)g.A + (size_t)nxt.pm * tstep : cA; const char* nB = has_next ? (const char*)g.Bt + (size_t)nxt.pn * tstep : cB;
        for (int t = 0; t < nt; t += 2) {
            const bool last = (t == nt - 2);
            const char* a1 = cA + (size_t)(t + 1) * kstep;
            const char* a2 = last ? nA : cA + (size_t)(t + 2) * kstep; const char* b2 = last ? nB : cB + (size_t)(t + 2) * kstep;
            const char* a3 = a2 + kstep; const char* b3 = b2 + kstep;
            if (last && has_next) S.a_ready(nxt);
            if constexpr (SP2) {
            PG8_LDB(B0, 0, 0); PG8_LDB(B1, 0, 1); PG8_SCHED; PG8_LDA(At, 0, 0); PG8_STAGE(PG8_SA(1, 1), a1 + hstep, voffA);
            PG8_WAIT_V(8); PG8_WAIT_L(0); PG8_BAR; PG8_MMA(0, 0, At, B0); PG8_MMA(0, 1, At, B1); PG8_BAR; PG8_SCHED;
            PG8_LDA(At, 0, 1); PG8_STAGE(PG8_SB(0, 0), b2, voffB); PG8_STAGE(PG8_SB(0, 1), b2 + hstep, voffB); PG8_STAGE(PG8_SA(0, 0), a2, voffA);
            PG8_WAIT_V(8); PG8_WAIT_L(0); PG8_BAR; PG8_MMA(1, 0, At, B0); PG8_MMA(1, 1, At, B1); PG8_BAR; PG8_SCHED;
            PG8_LDB(B0, 1, 0); PG8_LDB(B1, 1, 1); PG8_SCHED; PG8_LDA(At, 1, 0); PG8_STAGE(PG8_SA(0, 1), a2 + hstep, voffA);
            PG8_WAIT_V(8); PG8_WAIT_L(0); PG8_BAR; PG8_MMA(0, 0, At, B0); PG8_MMA(0, 1, At, B1); PG8_BAR; PG8_SCHED;
            PG8_LDA(At, 1, 1); PG8_STAGE(PG8_SB(1, 0), b3, voffB); PG8_STAGE(PG8_SB(1, 1), b3 + hstep, voffB); PG8_STAGE(PG8_SA(1, 0), a3, voffA);
            PG8_WAIT_V(8); PG8_WAIT_L(0); PG8_BAR; PG8_MMA(1, 0, At, B0); PG8_MMA(1, 1, At, B1); PG8_BAR; PG8_SCHED;
            } else {
            PG8_LDB(B0, 0, 0); PG8_SCHED; PG8_LDA(At, 0, 0); PG8_STAGE(PG8_SA(1, 1), a1 + hstep, voffA);
            PG8_WAIT_L(8); PG8_BAR; PG8_WAIT_L(0); PG8_MMA(0, 0, At, B0); PG8_BAR; PG8_SCHED;
            PG8_LDB(B1, 0, 1); PG8_STAGE(PG8_SB(0, 0), b2, voffB);
            PG8_BAR; PG8_WAIT_L(0); PG8_MMA(0, 1, At, B1); PG8_BAR;
            PG8_LDA(At, 0, 1); PG8_STAGE(PG8_SA(0, 0), a2, voffA);
            PG8_BAR; PG8_WAIT_L(0); PG8_MMA(1, 0, At, B0); PG8_BAR; PG8_SCHED;
            PG8_STAGE(PG8_SB(0, 1), b2 + hstep, voffB);
            PG8_WAIT_V(6); PG8_BAR; PG8_MMA(1, 1, At, B1); PG8_BAR;
            PG8_LDB(B0, 1, 0); PG8_SCHED; PG8_LDA(At, 1, 0); PG8_STAGE(PG8_SA(0, 1), a2 + hstep, voffA);
            PG8_WAIT_L(8); PG8_BAR; PG8_WAIT_L(0); PG8_MMA(0, 0, At, B0); PG8_BAR; PG8_SCHED;
            PG8_LDB(B1, 1, 1); PG8_STAGE(PG8_SB(1, 0), b3, voffB);
            PG8_BAR; PG8_WAIT_L(0); PG8_MMA(0, 1, At, B1); PG8_BAR;
            PG8_LDA(At, 1, 1); PG8_STAGE(PG8_SA(1, 0), a3, voffA);
            PG8_BAR; PG8_WAIT_L(0); PG8_MMA(1, 0, At, B0); PG8_BAR; PG8_SCHED;
            PG8_STAGE(PG8_SB(1, 1), b3 + hstep, voffB);
            PG8_WAIT_V(6); PG8_BAR; PG8_MMA(1, 1, At, B1); PG8_BAR;
            }
        }
        if constexpr (ALIGN_EPI) { if (wr == 0) PG8_BAR; }
        if constexpr (!Epi::AFTER_DRAIN) { E(acc, cur, wr, wc, fr, fq); S.done(cur); }
        if (!has_next) break;
#pragma unroll
        for (int a = 0; a < 2; ++a)
#pragma unroll
            for (int b = 0; b < 2; ++b)
#pragma unroll
                for (int m = 0; m < 4; ++m)
#pragma unroll
                    for (int n = 0; n < 2; ++n) acc[a][b][m][n] = (f32x4){0.f, 0.f, 0.f, 0.f};
        cur = nxt; cA = nA; cB = nB; ++ui;
        if constexpr (ALIGN_EPI) { if (wr == 1) PG8_BAR; }
    }
    PG8_WAIT_V(0);
    if constexpr (!ALIGN_EPI) { if (wr == 0) PG8_BAR; }
    PG8_BAR;
    if constexpr (Epi::AFTER_DRAIN) { E.fused(acc, cur, wr, wc, fr, fq, lds, wid, lane); S.done(cur); }
#undef PG8_SA
#undef PG8_SB
#undef PG8_STAGE
#undef PG8_LDA
#undef PG8_LDB
#undef PG8_MMA
#undef PG8_WAIT_V
#undef PG8_WAIT_L
#undef PG8_BAR
#undef PG8_SCHED
}
}
#define LAS __attribute__((address_space(3)))
typedef unsigned short bf16_t;
typedef short bf16x8 __attribute__((ext_vector_type(8)));
typedef short s16x4 __attribute__((ext_vector_type(4)));
typedef float f32x4 __attribute__((ext_vector_type(4)));
typedef float f32x2 __attribute__((ext_vector_type(2)));
typedef unsigned u32x4 __attribute__((ext_vector_type(4)));
typedef unsigned u32x2 __attribute__((ext_vector_type(2)));

constexpr int T_ = 32768, D_ = 1024, S_ = 2048, NB_ = 16, NCOL_ = 8192;
constexpr float EPS_ = 1e-6f;
constexpr size_t MiB = 1u << 20;
constexpr size_t WS_WIN = 0, WS_WPA = 16 * MiB, WS_WPB = 18 * MiB, WS_WOUT = 20 * MiB;
constexpr size_t WS_COS = 22 * MiB, WS_SIN = 23 * MiB, WS_STAT = 24 * MiB, WS_SSQ = 28 * MiB;
constexpr size_t WS_CTL = 30 * MiB, CTL_BYTES = 16384 + 128 * 256, WS_XSLOT = 31 * MiB;
constexpr size_t WS_SEG0 = 32 * MiB, SEG_BYTES = 64 * MiB, SEG_ELEMS = SEG_BYTES / 2;
constexpr size_t WS_END = WS_SEG0 + 7 * SEG_BYTES;
constexpr int LDS_BYTES = 152 * 1024;

__device__ __forceinline__ unsigned f2bf(float f) { unsigned u = __builtin_bit_cast(unsigned, f); return (u + 0x7fffu + ((u >> 16) & 1u)) >> 16; }
__device__ __forceinline__ unsigned pk2(float lo, float hi) { return pg8::cvt_pk_bf16(lo, hi); }
__device__ __forceinline__ float bf_lo(unsigned w) { return __builtin_bit_cast(float, w << 16); }
__device__ __forceinline__ float bf_hi(unsigned w) { return __builtin_bit_cast(float, w & 0xffff0000u); }
__device__ __forceinline__ float bf1(bf16_t b) { return __builtin_bit_cast(float, ((unsigned)b) << 16); }
__device__ __forceinline__ float sigm(float x) { return __builtin_amdgcn_rcpf(1.0f + __expf(-x)); }
__device__ __forceinline__ float wave_sum(float v) {
#pragma unroll
    for (int o = 1; o < 64; o <<= 1) v += __shfl_xor(v, o);
    return v;
}

struct EpiProj {
    static constexpr bool PERM = true, AFTER_DRAIN = false;
    bf16_t* seg0; bf16_t* mbp; const float* cosT; const float* sinT;
    __device__ __forceinline__ void operator()(const f32x4 (&acc)[2][2][4][2], const pg8::Unit& u, int wr, int wc, int fr, int fq) const {
        const int seg = u.pn >> 2, ct = (u.pn & 3) * 256;
        bf16_t* base = (seg == 7) ? mbp : seg0 + (size_t)seg * SEG_ELEMS;
        const int row0 = u.pm * 256 + wr * 64 + fr, col0 = ct + wc * 32 + 8 * fq;
        if (seg == 2 || seg == 3) {
            const int hh = u.pn & 3;
            const float lg = log2f(1.0f - exp2f(-5.0f - (float)hh));
            const int j0 = wc * 32 + 8 * fq;
#pragma unroll
            for (int ai = 0; ai < 2; ++ai)
#pragma unroll
                for (int m = 0; m < 4; ++m) {
                    const int row = row0 + ai * 128 + m * 16, s = row & (S_ - 1);
                    const float jj = (float)(s & 127);
                    const float sc = (seg == 2) ? exp2f(jj * lg) : exp2f(-jj * lg) * 0.0625f;
                    const f32x4 c0 = *(const f32x4*)(cosT + s * 128 + j0), c1 = *(const f32x4*)(cosT + s * 128 + j0 + 4);
                    const f32x4 s0 = *(const f32x4*)(sinT + s * 128 + j0), s1 = *(const f32x4*)(sinT + s * 128 + j0 + 4);
                    const f32x4 x10 = acc[ai][0][m][0], x11 = acc[ai][0][m][1], x20 = acc[ai][1][m][0], x21 = acc[ai][1][m][1];
                    const f32x4 y10 = (x10 * c0 - x20 * s0) * sc, y11 = (x11 * c1 - x21 * s1) * sc;
                    const f32x4 y20 = (x10 * s0 + x20 * c0) * sc, y21 = (x11 * s1 + x21 * c1) * sc;
                    bf16_t* rowp = base + (size_t)row * D_ + col0;
                    u32x4 w1, w2;
                    w1.x = pk2(y10[0], y10[1]); w1.y = pk2(y10[2], y10[3]); w1.z = pk2(y11[0], y11[1]); w1.w = pk2(y11[2], y11[3]);
                    w2.x = pk2(y20[0], y20[1]); w2.y = pk2(y20[2], y20[3]); w2.z = pk2(y21[0], y21[1]); w2.w = pk2(y21[2], y21[3]);
                    __builtin_nontemporal_store(w1, (u32x4*)(rowp)); __builtin_nontemporal_store(w2, (u32x4*)(rowp + 128));
                }
        } else {
            const int act = (seg >= 6) ? 2 : 0;
#pragma unroll
            for (int ai = 0; ai < 2; ++ai)
#pragma unroll
                for (int m = 0; m < 4; ++m) {
                    bf16_t* rowp = base + (size_t)(row0 + ai * 128 + m * 16) * D_ + col0;
#pragma unroll
                    for (int bj = 0; bj < 2; ++bj) {
                        f32x4 v0 = acc[ai][bj][m][0], v1 = acc[ai][bj][m][1];
                        if (act) {
#pragma unroll
                            for (int e = 0; e < 4; ++e) {
                                const float g0 = sigm(v0[e]), g1 = sigm(v1[e]);
                                v0[e] = (act == 1) ? v0[e] * g0 : g0; v1[e] = (act == 1) ? v1[e] * g1 : g1;
                            }
                        }
                        u32x4 w; w.x = pk2(v0[0], v0[1]); w.y = pk2(v0[2], v0[3]); w.z = pk2(v1[0], v1[1]); w.w = pk2(v1[2], v1[3]);
                        __builtin_nontemporal_store(w, (u32x4*)(rowp + bj * 128));
                    }
                }
        }
    }
};
template <int MODE> struct EpiGate {
    static constexpr bool PERM = true, AFTER_DRAIN = false;
    const bf16_t* gate; bf16_t* out;
    __device__ __forceinline__ void operator()(const f32x4 (&acc)[2][2][4][2], const pg8::Unit& u, int wr, int wc, int fr, int fq) const {
        const int row0 = u.pm * 256 + wr * 64 + fr, col0 = u.pn * 256 + wc * 32 + 8 * fq;
#pragma unroll
        for (int ai = 0; ai < 2; ++ai)
#pragma unroll
            for (int m = 0; m < 4; ++m)
#pragma unroll
                for (int bj = 0; bj < 2; ++bj) {
                    const size_t off = (size_t)(row0 + ai * 128 + m * 16) * D_ + col0 + bj * 128;
                    const u32x4 gv = *(const u32x4*)(gate + off);
                    f32x4 v0 = acc[ai][bj][m][0], v1 = acc[ai][bj][m][1];
                    v0[0] *= bf_lo(gv.x); v0[1] *= bf_hi(gv.x); v0[2] *= bf_lo(gv.y); v0[3] *= bf_hi(gv.y);
                    v1[0] *= bf_lo(gv.z); v1[1] *= bf_hi(gv.z); v1[2] *= bf_lo(gv.w); v1[3] *= bf_hi(gv.w);
                    if (MODE == 1) {
                        const u32x4 pv = *(const u32x4*)(out + off);
                        v0[0] += bf_lo(pv.x); v0[1] += bf_hi(pv.x); v0[2] += bf_lo(pv.y); v0[3] += bf_hi(pv.y);
                        v1[0] += bf_lo(pv.z); v1[1] += bf_hi(pv.z); v1[2] += bf_lo(pv.w); v1[3] += bf_hi(pv.w);
                    }
                    u32x4 w; w.x = pk2(v0[0], v0[1]); w.y = pk2(v0[2], v0[3]); w.z = pk2(v1[0], v1[1]); w.w = pk2(v1[2], v1[3]);
                    *(u32x4*)(out + off) = w;
                }
    }
};
struct EpiResid {
    static constexpr bool PERM = false, AFTER_DRAIN = false;
    const float* x; bf16_t* out; float* ssq;
    __device__ __forceinline__ void operator()(const f32x4 (&acc)[2][2][4][2], const pg8::Unit& u, int wr, int wc, int fr, int fq) const {
        const int row0 = u.pm * 256 + wr * 64 + fr, col0 = u.pn * 256 + wc * 32 + 4 * fq;
#pragma unroll
        for (int ai = 0; ai < 2; ++ai)
#pragma unroll
            for (int m = 0; m < 4; ++m) {
                const int row = row0 + ai * 128 + m * 16; float q = 0.f;
#pragma unroll
                for (int bj = 0; bj < 2; ++bj)
#pragma unroll
                    for (int n = 0; n < 2; ++n) {
                        const size_t off = (size_t)row * D_ + col0 + bj * 128 + n * 16;
                        const f32x4 o = *(const f32x4*)(x + off) + acc[ai][bj][m][n];
                        u32x2 pkd; pkd.x = pk2(o[0], o[1]); pkd.y = pk2(o[2], o[3]);
                        *(u32x2*)(out + off) = pkd;
                        q += (o[0] * o[0] + o[1] * o[1]) + (o[2] * o[2] + o[3] * o[3]);
                    }
                q += __shfl_xor(q, 16); q += __shfl_xor(q, 32);
                if (fq == 0) ssq[(size_t)(u.pn * 4 + wc) * T_ + row] = q;
            }
    }
};


struct EpiResidNorm {
    static constexpr bool PERM = false, AFTER_DRAIN = true;
    const float* x; float* out; const float* gfin; float* xslots; unsigned* cnt;
    __device__ __forceinline__ void fused(f32x4 (&acc)[2][2][4][2], const pg8::Unit& u, int wr, int wc, int fr, int fq, LAS unsigned char* lds, int wid, int lane) const {
        LAS float* P = (LAS float*)lds;
        LAS float* Srs = (LAS float*)(lds + 4096);
        const int row0 = u.pm * 256 + wr * 64 + fr, col0 = u.pn * 256 + wc * 32 + 4 * fq;
#pragma unroll
        for (int ai = 0; ai < 2; ++ai)
#pragma unroll
            for (int m = 0; m < 4; ++m) {
                const size_t rbase = (size_t)(row0 + ai * 128 + m * 16) * D_ + col0; float q = 0.f;
#pragma unroll
                for (int bj = 0; bj < 2; ++bj)
#pragma unroll
                    for (int n = 0; n < 2; ++n) {
                        const f32x4 o = *(const f32x4*)(x + rbase + bj * 128 + n * 16) + acc[ai][bj][m][n];
                        acc[ai][bj][m][n] = o;
                        q += (o[0] * o[0] + o[1] * o[1]) + (o[2] * o[2] + o[3] * o[3]);
                    }
                q += __shfl_xor(q, 16); q += __shfl_xor(q, 32);
                if (fq == 0) P[(ai * 128 + wr * 64 + m * 16 + fr) * 4 + wc] = q;
                asm volatile("" ::: "memory");
            }
        asm volatile("s_waitcnt lgkmcnt(0)" ::: "memory"); __builtin_amdgcn_s_barrier(); asm volatile("" ::: "memory");
        const int rl = wid * 32 + (lane & 31);
        if (lane < 32) {
            const f32x4 p = *(const LAS f32x4*)(P + rl * 4);
            __hip_atomic_store(xslots + (size_t)(u.pm * 256 + rl) * 4 + u.pn, (p[0] + p[1]) + (p[2] + p[3]), __ATOMIC_RELAXED, __HIP_MEMORY_SCOPE_AGENT);
        }
        asm volatile("s_waitcnt vmcnt(0)" ::: "memory");
        if (lane == 0) __hip_atomic_fetch_add(cnt + 64 * u.pm, 1u, __ATOMIC_RELAXED, __HIP_MEMORY_SCOPE_AGENT);
        if (wid == 0) {
            unsigned spins = 0;
            while ((unsigned)__builtin_amdgcn_readfirstlane(__hip_atomic_load(cnt + 64 * u.pm, __ATOMIC_RELAXED, __HIP_MEMORY_SCOPE_AGENT)) < 32u) {
                __builtin_amdgcn_s_sleep(2);
                if (++spins > (1u << 22)) break;
            }
            __builtin_amdgcn_fence(__ATOMIC_ACQUIRE, "agent");
        }
        asm volatile("s_waitcnt vmcnt(0) lgkmcnt(0)" ::: "memory"); __builtin_amdgcn_s_barrier(); asm volatile("" ::: "memory");
        if (lane < 32) {
            const float* sl = xslots + (size_t)(u.pm * 256 + rl) * 4; float s = 0.f;
#pragma unroll
            for (int t = 0; t < 4; ++t) s += __hip_atomic_load(sl + t, __ATOMIC_RELAXED, __HIP_MEMORY_SCOPE_AGENT);
            Srs[rl] = 1.0f / sqrtf(s * (1.0f / D_) + EPS_);
        }
        asm volatile("s_waitcnt lgkmcnt(0)" ::: "memory"); __builtin_amdgcn_s_barrier(); asm volatile("" ::: "memory");
        f32x4 gv[2][2];
#pragma unroll
        for (int bj = 0; bj < 2; ++bj)
#pragma unroll
            for (int n = 0; n < 2; ++n) gv[bj][n] = *(const f32x4*)(gfin + col0 + bj * 128 + n * 16);
#pragma unroll
        for (int ai = 0; ai < 2; ++ai)
#pragma unroll
            for (int m = 0; m < 4; ++m) {
                const float rs = Srs[ai * 128 + wr * 64 + m * 16 + fr];
                const size_t rbase = (size_t)(row0 + ai * 128 + m * 16) * D_ + col0;
#pragma unroll
                for (int bj = 0; bj < 2; ++bj)
#pragma unroll
                    for (int n = 0; n < 2; ++n) *(f32x4*)(out + rbase + bj * 128 + n * 16) = acc[ai][bj][m][n] * rs * gv[bj][n];
            }
        asm volatile("s_waitcnt lgkmcnt(0)" ::: "memory"); __builtin_amdgcn_s_barrier(); asm volatile("" ::: "memory");
    }
};

__device__ __forceinline__ void p0_transpose_item(const float* W, int K, int N, bf16_t* WT, LAS float* scr, int item, int lane) {
    const int nblk = N / 32, kb = item / nblk, nb = item % nblk, k0 = 64 * kb, n0 = 32 * nb;
#pragma unroll 8
    for (int i = 0; i < 32; ++i) { const int kk = 2 * i + (lane >> 5); scr[kk * 33 + (lane & 31)] = W[(size_t)(k0 + kk) * N + n0 + (lane & 31)]; }
    asm volatile("s_waitcnt lgkmcnt(0)" ::: "memory");
    const int c = lane & 7;
#pragma unroll
    for (int j = 0; j < 4; ++j) { const int n = (lane >> 3) + 8 * j; const LAS float* s = scr + (8 * c) * 33 + n;
        u32x4 o; o.x = pk2(s[0 * 33], s[1 * 33]); o.y = pk2(s[2 * 33], s[3 * 33]); o.z = pk2(s[4 * 33], s[5 * 33]); o.w = pk2(s[6 * 33], s[7 * 33]);
        *(u32x4*)(WT + (size_t)(n0 + n) * K + k0 + 8 * c) = o; }
    asm volatile("s_waitcnt lgkmcnt(0)" ::: "memory");
}
__device__ __forceinline__ void p0_prologue(LAS unsigned char* lds, const float* x, const float* norm_in, const float* w_in, const float* w_pa, const float* w_pb, const float* w_out,
                                            bf16_t* WinT, bf16_t* WpaT, bf16_t* WpbT, bf16_t* WoutT, bf16_t* H, float* cosT, float* sinT) {
    const int tid = threadIdx.x, lane = tid & 63, wave = __builtin_amdgcn_readfirstlane(tid >> 6);
    LAS float* scr = (LAS float*)(lds + wave * 16384);
    const int gw = blockIdx.x * 8 + wave, NGW = gridDim.x * 8;
    constexpr int I_IN = (D_ / 64) * (NCOL_ / 32), I_SQ = (D_ / 64) * (D_ / 32);
    for (int it = gw; it < I_IN + 3 * I_SQ; it += NGW) {
        int r = it;
        if (r < I_IN) { p0_transpose_item(w_in, D_, NCOL_, WinT, scr, r, lane); continue; } r -= I_IN;
        if (r < I_SQ) { p0_transpose_item(w_pa, D_, D_, WpaT, scr, r, lane); continue; } r -= I_SQ;
        if (r < I_SQ) { p0_transpose_item(w_pb, D_, D_, WpbT, scr, r, lane); continue; } r -= I_SQ;
        p0_transpose_item(w_out, D_, D_, WoutT, scr, r, lane);
    }
    for (int idx = blockIdx.x * 512 + tid; idx < S_ * 128; idx += gridDim.x * 512) {
        const int s = idx >> 7, j = idx & 127;
        const float freq = exp2f(-(float)j * (1.0f / 128.0f) * 13.287712379549449f);
        const float ang = (float)s * freq;
        double rev = (double)ang * 0.15915494309189535; rev -= __builtin_rint(rev);
        const float r = (float)rev;
        cosT[idx] = __builtin_amdgcn_cosf(r); sinT[idx] = __builtin_amdgcn_sinf(r);
    }
    const f32x4* gp = (const f32x4*)norm_in + lane;
    f32x4 gv[4];
#pragma unroll
    for (int j = 0; j < 4; ++j) gv[j] = gp[64 * j];
    for (int m = gw; m < T_; m += 2 * NGW) {
        const f32x4* xr0 = (const f32x4*)(x + (size_t)m * D_) + lane; const f32x4* xr1 = (const f32x4*)(x + (size_t)(m + NGW) * D_) + lane;
        f32x4 v0[4], v1[4]; float ss0 = 0.f, ss1 = 0.f;
#pragma unroll
        for (int j = 0; j < 4; ++j) { v0[j] = __builtin_nontemporal_load(xr0 + 64 * j); v1[j] = __builtin_nontemporal_load(xr1 + 64 * j); }
#pragma unroll
        for (int j = 0; j < 4; ++j) { ss0 += (v0[j][0] * v0[j][0] + v0[j][1] * v0[j][1]) + (v0[j][2] * v0[j][2] + v0[j][3] * v0[j][3]);
                                      ss1 += (v1[j][0] * v1[j][0] + v1[j][1] * v1[j][1]) + (v1[j][2] * v1[j][2] + v1[j][3] * v1[j][3]); }
        const float rs0 = 1.0f / sqrtf(wave_sum(ss0) * (1.0f / D_) + EPS_), rs1 = 1.0f / sqrtf(wave_sum(ss1) * (1.0f / D_) + EPS_);
        u32x2* o0 = (u32x2*)(H + (size_t)m * D_) + lane; u32x2* o1 = (u32x2*)(H + (size_t)(m + NGW) * D_) + lane;
#pragma unroll
        for (int j = 0; j < 4; ++j) { u32x2 o; o.x = pk2(v0[j][0] * rs0 * gv[j][0], v0[j][1] * rs0 * gv[j][1]); o.y = pk2(v0[j][2] * rs0 * gv[j][2], v0[j][3] * rs0 * gv[j][3]); o0[64 * j] = o;
                                      u32x2 p; p.x = pk2(v1[j][0] * rs1 * gv[j][0], v1[j][1] * rs1 * gv[j][1]); p.y = pk2(v1[j][2] * rs1 * gv[j][2], v1[j][3] * rs1 * gv[j][3]); o1[64 * j] = p; }
    }
}

#define TR16(p) __builtin_amdgcn_ds_read_tr16_b64_v4i16((LAS s16x4*)(p))
#define MFMA16(a, b, c) __builtin_amdgcn_mfma_f32_16x16x32_bf16((a), (b), (c), 0, 0, 0)
__device__ __forceinline__ bf16x8 cat8(s16x4 a, s16x4 b) { return (bf16x8){a[0], a[1], a[2], a[3], b[0], b[1], b[2], b[3]}; }
__device__ __forceinline__ void ret_item(LAS unsigned char* lds, int item, const bf16_t* Qb, const bf16_t* Kb, const bf16_t* Vb, bf16_t* Oraw, f32x2* stats) {
    const int tid = threadIdx.x, w = __builtin_amdgcn_readfirstlane(tid >> 6), lane = tid & 63, n16 = lane & 15, g = lane >> 4, q4 = (lane & 15) >> 2, p4 = lane & 3;
    const int b = item >> 4, h = (item >> 2) & 3, es = item & 3;
    constexpr int KSB = 528, VSB = 144;
    LAS unsigned char* Ks = lds; LAS unsigned char* Vs = lds + 67584; LAS unsigned char* Rb = lds + 86016;
    const float lg = log2f(1.0f - exp2f(-5.0f - (float)h)); const float g128 = exp2f(128.0f * lg);
    f32x4 R[2][4];
#pragma unroll
    for (int a = 0; a < 2; ++a)
#pragma unroll
        for (int e = 0; e < 4; ++e) R[a][e] = (f32x4){0.f, 0.f, 0.f, 0.f};
    __syncthreads();
    for (int i = tid; i < 33792 / 16; i += 512) *(LAS u32x4*)(Rb + i * 16) = (u32x4){0u, 0u, 0u, 0u};
    const size_t rowbase = (size_t)b * S_;
    const bf16_t* Kg = Kb + rowbase * D_ + h * 256; const bf16_t* Vg = Vb + rowbase * D_ + h * 256 + es * 64; const bf16_t* Qg = Qb + rowbase * D_ + h * 256;
    u32x4 kreg[8], vreg[2];
#define RET_LOADKV(c) do { _Pragma("unroll") for (int i = 0; i < 8; ++i) { const int idx = tid + 512 * i; kreg[i] = *(const u32x4*)(Kg + (size_t)((c) * 128 + (idx >> 5)) * D_ + (idx & 31) * 8); } \
        _Pragma("unroll") for (int i = 0; i < 2; ++i) { const int idx = tid + 512 * i; vreg[i] = *(const u32x4*)(Vg + (size_t)((c) * 128 + (idx >> 3)) * D_ + (idx & 7) * 8); } } while (0)
    bf16x8 Qf[8];
#define RET_LOADQ(c) do { _Pragma("unroll") for (int ks = 0; ks < 8; ++ks) Qf[ks] = *(const bf16x8*)(Qg + (size_t)((c) * 128 + 16 * w + n16) * D_ + 32 * ks + 8 * g); } while (0)
    RET_LOADKV(0); RET_LOADQ(0);
    for (int c = 0; c < 16; ++c) {
#pragma unroll
        for (int i = 0; i < 8; ++i) { const int idx = tid + 512 * i; *(LAS u32x4*)(Ks + (idx >> 5) * KSB + (idx & 31) * 16) = kreg[i]; }
#pragma unroll
        for (int i = 0; i < 2; ++i) { const int idx = tid + 512 * i; *(LAS u32x4*)(Vs + (idx >> 3) * VSB + (idx & 7) * 16) = vreg[i]; }
        __syncthreads();
        f32x4 O[4];
#pragma unroll
        for (int et = 0; et < 4; ++et) O[et] = (f32x4){0.f, 0.f, 0.f, 0.f};
#pragma unroll
        for (int kk = 0; kk < 4; ++kk) if (2 * kk <= w) {
            f32x4 ST0 = (f32x4){0.f, 0.f, 0.f, 0.f}, ST1 = ST0;
#pragma unroll
            for (int ks = 0; ks < 8; ++ks) { const bf16x8 a = *(const LAS bf16x8*)(Ks + (32 * kk + n16) * KSB + (32 * ks + 8 * g) * 2); ST0 = MFMA16(a, Qf[ks], ST0); }
            if (2 * kk + 1 <= w) {
#pragma unroll
                for (int ks = 0; ks < 8; ++ks) { const bf16x8 a = *(const LAS bf16x8*)(Ks + (32 * kk + 16 + n16) * KSB + (32 * ks + 8 * g) * 2); ST1 = MFMA16(a, Qf[ks], ST1); }
            }
            if (2 * kk == w) {
#pragma unroll
                for (int r = 0; r < 4; ++r) if (4 * g + r > n16) ST0[r] = 0.f;
            }
            if (2 * kk + 1 == w) {
#pragma unroll
                for (int r = 0; r < 4; ++r) if (4 * g + r > n16) ST1[r] = 0.f;
            }
            bf16x8 pb;
            { const unsigned a0 = pk2(ST0[0], ST0[1]), a1 = pk2(ST0[2], ST0[3]), a2 = pk2(ST1[0], ST1[1]), a3 = pk2(ST1[2], ST1[3]);
              pb = __builtin_bit_cast(bf16x8, (u32x4){a0, a1, a2, a3}); }
#pragma unroll
            for (int et = 0; et < 4; ++et) {
                const s16x4 v0 = TR16(Vs + (32 * kk + 4 * g + q4) * VSB + (16 * et + 4 * p4) * 2);
                const s16x4 v1 = TR16(Vs + (32 * kk + 16 + 4 * g + q4) * VSB + (16 * et + 4 * p4) * 2);
                O[et] = MFMA16(cat8(v0, v1), pb, O[et]);
            }
        }
        if (c + 1 < 16) { RET_LOADKV(c + 1); }
#pragma unroll
        for (int ks = 0; ks < 8; ++ks)
#pragma unroll
            for (int et = 0; et < 4; ++et) { const bf16x8 a = *(const LAS bf16x8*)(Rb + (16 * et + n16) * KSB + (32 * ks + 8 * g) * 2); O[et] = MFMA16(a, Qf[ks], O[et]); }
        {
            const size_t tok = rowbase + c * 128 + 16 * w + n16; float s1 = 0.f, s2 = 0.f;
#pragma unroll
            for (int et = 0; et < 4; ++et) {
                const f32x4 o = O[et];
                s1 += (o[0] + o[1]) + (o[2] + o[3]); s2 += (o[0] * o[0] + o[1] * o[1]) + (o[2] * o[2] + o[3] * o[3]);
                u32x2 pkd; pkd.x = pk2(o[0], o[1]); pkd.y = pk2(o[2], o[3]);
                *(u32x2*)(Oraw + tok * D_ + h * 256 + es * 64 + 16 * et + 4 * g) = pkd;
            }
            s1 += __shfl_xor(s1, 16); s1 += __shfl_xor(s1, 32); s2 += __shfl_xor(s2, 16); s2 += __shfl_xor(s2, 32);
            if (g == 0) stats[(size_t)(es * 4 + h) * T_ + tok] = (f32x2){s1, s2};
        }
        if (c + 1 < 16) { RET_LOADQ(c + 1); }
#pragma unroll
        for (int a = 0; a < 2; ++a)
#pragma unroll
            for (int e = 0; e < 4; ++e) R[a][e] = R[a][e] * g128;
#pragma unroll 1
        for (int ks = 0; ks < 4; ++ks) {
            bf16x8 ka[2], vb[4];
#pragma unroll
            for (int dt = 0; dt < 2; ++dt) {
                const s16x4 t0 = TR16(Ks + (32 * ks + 8 * g + q4) * KSB + (32 * w + 16 * dt + 4 * p4) * 2);
                const s16x4 t1 = TR16(Ks + (32 * ks + 8 * g + 4 + q4) * KSB + (32 * w + 16 * dt + 4 * p4) * 2);
                ka[dt] = cat8(t0, t1);
            }
#pragma unroll
            for (int et = 0; et < 4; ++et) {
                const s16x4 t0 = TR16(Vs + (32 * ks + 8 * g + q4) * VSB + (16 * et + 4 * p4) * 2);
                const s16x4 t1 = TR16(Vs + (32 * ks + 8 * g + 4 + q4) * VSB + (16 * et + 4 * p4) * 2);
                vb[et] = cat8(t0, t1);
            }
#pragma unroll
            for (int dt = 0; dt < 2; ++dt)
#pragma unroll
                for (int et = 0; et < 4; ++et) R[dt][et] = MFMA16(ka[dt], vb[et], R[dt][et]);
        }
        __syncthreads();
#pragma unroll
        for (int dt = 0; dt < 2; ++dt)
#pragma unroll
            for (int et = 0; et < 4; ++et) { const f32x4 rs_ = R[dt][et] * g128; u32x2 pkd; pkd.x = pk2(rs_[0], rs_[1]); pkd.y = pk2(rs_[2], rs_[3]);
                *(LAS u32x2*)(Rb + (16 * et + n16) * KSB + (32 * w + 16 * dt + 4 * g) * 2) = pkd; }
    }
#undef RET_LOADKV
#undef RET_LOADQ
}


struct GnRow { u32x4 ov[2], gv[2]; f32x2 st[2][4]; };
__device__ __forceinline__ void gn_row_load(GnRow& R, const bf16_t* Oraw, const f32x2* stats, const bf16_t* GB, int row, int lane) {
#pragma unroll
    for (int half = 0; half < 2; ++half) {
        const int p = lane + 64 * half, hh = p >> 5; const size_t off = (size_t)row * D_ + p * 8;
        R.ov[half] = __builtin_nontemporal_load((const u32x4*)(Oraw + off)); R.gv[half] = __builtin_nontemporal_load((const u32x4*)(GB + off));
#pragma unroll
        for (int k = 0; k < 4; ++k) R.st[half][k] = stats[(size_t)(k * 4 + hh) * T_ + row];
    }
}
__device__ __forceinline__ void gn_row_finish(const GnRow& R, const f32x4 (&gnv)[2][2], bf16_t* GB, int row, int lane) {
#pragma unroll
    for (int half = 0; half < 2; ++half) {
        const int p = lane + 64 * half; const size_t off = (size_t)row * D_ + p * 8;
        const float mu = ((R.st[half][0][0] + R.st[half][1][0]) + (R.st[half][2][0] + R.st[half][3][0])) * (1.0f / 256.0f);
        const float var = ((R.st[half][0][1] + R.st[half][1][1]) + (R.st[half][2][1] + R.st[half][3][1])) * (1.0f / 256.0f) - mu * mu;
        const float rstd = 1.0f / sqrtf(fmaxf(var, 0.f) + EPS_);
        const u32x4 ov = R.ov[half], gv = R.gv[half];
        const f32x4 g0 = gnv[half][0], g1 = gnv[half][1];
        float gt[8] = {bf_lo(gv.x), bf_hi(gv.x), bf_lo(gv.y), bf_hi(gv.y), bf_lo(gv.z), bf_hi(gv.z), bf_lo(gv.w), bf_hi(gv.w)};
        const float oo[8] = {bf_lo(ov.x), bf_hi(ov.x), bf_lo(ov.y), bf_hi(ov.y), bf_lo(ov.z), bf_hi(ov.z), bf_lo(ov.w), bf_hi(ov.w)};
        const float gg[8] = {g0[0], g0[1], g0[2], g0[3], g1[0], g1[1], g1[2], g1[3]};
        float y[8];
#pragma unroll
        for (int q_ = 0; q_ < 8; ++q_) y[q_] = gt[q_] * sigm(gt[q_]) * ((oo[q_] - mu) * rstd * gg[q_]);
        u32x4 o; o.x = pk2(y[0], y[1]); o.y = pk2(y[2], y[3]); o.z = pk2(y[4], y[5]); o.w = pk2(y[6], y[7]);
        __builtin_nontemporal_store(o, (u32x4*)(GB + off));
    }
}
__device__ __forceinline__ void lru_item(LAS unsigned char* lds, int item, const bf16_t* XA, bf16_t* GY, const float* conv_w, const float* conv_b,
                                         const float* gxw, const float* gxb, const float* gaw, const float* gab, const float* lam,
                                         const bf16_t* Oraw, const f32x2* stats, const float* gain, bf16_t* GB, int gn_row0, int gn_stride) {
    const int tid = threadIdx.x, w = __builtin_amdgcn_readfirstlane(tid >> 6), lane = tid & 63, n16 = lane & 15, g = lane >> 4;
    const int b = item >> 4, n = item & 15;
    constexpr int XRB = 144, SGB = 128, XBB = 144, XS = 68;
    LAS unsigned char* XRw = lds + w * 2736; LAS unsigned char* SG = lds + 21888; LAS unsigned char* XCB = lds + 38272; LAS unsigned char* WX = lds + 56704; LAS unsigned char* WA = lds + 65920;
    LAS float* AF = (LAS float*)(lds + 75136); LAS float* UF = (LAS float*)(lds + 109952); LAS f32x2* SEG0 = (LAS f32x2*)(lds + 144768);
    LAS float* CW = (LAS float*)(lds + 152960); LAS float* CB = CW + 256; LAS float* BX = CW + 320; LAS float* BA = CW + 384; LAS float* SP = CW + 448;
    __syncthreads();
#pragma unroll
    for (int i = 0; i < 8; ++i) { const int idx = tid + 512 * i, k = idx >> 6, j = idx & 63;
        *(LAS bf16_t*)(WX + j * XBB + k * 2) = (bf16_t)f2bf(gxw[(size_t)n * 4096 + idx]);
        *(LAS bf16_t*)(WA + j * XBB + k * 2) = (bf16_t)f2bf(gaw[(size_t)n * 4096 + idx]); }
    if (tid < 256) CW[tid] = conv_w[(tid >> 6) * D_ + n * 64 + (tid & 63)];
    if (tid < 64) { CB[tid] = conv_b[n * 64 + tid]; BX[tid] = gxb[n * 64 + tid]; BA[tid] = gab[n * 64 + tid]; SP[tid] = log1pf(expf(-lam[n * 64 + tid])); }
    const int tl = tid >> 2, cgp = tid & 3;
    const bf16_t* xab = XA + (size_t)b * S_ * D_ + n * 64 + cgp * 16;
    bf16_t* gyb = GY + (size_t)b * S_ * D_ + n * 64;
    u32x4 xr0, xr1, sr0, sr1, hx0, hx1;
    const int hrow = lane >> 2;
#define LRU_LOAD(t0_) do { const u32x4* p_ = (const u32x4*)(xab + (size_t)((t0_) + tl) * D_); xr0 = __builtin_nontemporal_load(p_); xr1 = __builtin_nontemporal_load(p_ + 1); \
        const u32x4* q_ = (const u32x4*)(gyb + (size_t)((t0_) + tl) * D_ + cgp * 16); sr0 = __builtin_nontemporal_load(q_); sr1 = __builtin_nontemporal_load(q_ + 1); \
        hx0 = (u32x4){0u, 0u, 0u, 0u}; hx1 = hx0; \
        { const int th_ = (t0_) + 16 * w - 3 + hrow; if (lane < 12 && th_ >= 0) { const u32x4* h_ = (const u32x4*)(xab + (size_t)th_ * D_); hx0 = h_[0]; hx1 = h_[1]; } } } while (0)
#define LRU_STAGE() do { *(LAS u32x4*)(XRw + (3 + (lane >> 2)) * XRB + cgp * 32) = xr0; *(LAS u32x4*)(XRw + (3 + (lane >> 2)) * XRB + cgp * 32 + 16) = xr1; \
        if (lane < 12) { *(LAS u32x4*)(XRw + hrow * XRB + cgp * 32) = hx0; *(LAS u32x4*)(XRw + hrow * XRB + cgp * 32 + 16) = hx1; } \
        *(LAS u32x4*)(SG + tl * SGB + cgp * 32) = sr0; *(LAS u32x4*)(SG + tl * SGB + cgp * 32 + 16) = sr1; } while (0)
    LRU_LOAD(0); LRU_STAGE(); LRU_LOAD(128);
    __syncthreads();
    float state = 0.f;
    const int trow = 16 * w + n16;
    f32x4 gnv[2][2];
#pragma unroll
    for (int half = 0; half < 2; ++half) { gnv[half][0] = *(const f32x4*)(gain + (lane + 64 * half) * 8); gnv[half][1] = *(const f32x4*)(gain + (lane + 64 * half) * 8 + 4); }
    for (int tt = 0; tt < 16; ++tt) {
        const int t0 = tt * 128;
        GnRow gnr; gn_row_load(gnr, Oraw, stats, GB, gn_row0 + tt * gn_stride, lane);
        f32x4 xcv[4];
#pragma unroll
        for (int jt = 0; jt < 4; ++jt) {
            const int j0 = 16 * jt + 4 * g;
            f32x4 acc = *(const LAS f32x4*)(CB + j0);
#pragma unroll
            for (int k = 0; k < 4; ++k) {
                const f32x4 cwv = *(const LAS f32x4*)(CW + k * 64 + j0);
                const u32x2 raw = *(const LAS u32x2*)(XRw + (n16 + k) * XRB + j0 * 2);
                acc[0] += cwv[0] * bf_lo(raw.x); acc[1] += cwv[1] * bf_hi(raw.x); acc[2] += cwv[2] * bf_lo(raw.y); acc[3] += cwv[3] * bf_hi(raw.y);
            }
            xcv[jt] = acc;
            u32x2 pkd; pkd.x = pk2(acc[0], acc[1]); pkd.y = pk2(acc[2], acc[3]);
            *(LAS u32x2*)(XCB + trow * XBB + j0 * 2) = pkd;
        }
        __builtin_amdgcn_wave_barrier();
        {
            bf16x8 xb[2];
#pragma unroll
            for (int ks = 0; ks < 2; ++ks) xb[ks] = *(const LAS bf16x8*)(XCB + trow * XBB + (32 * ks + 8 * g) * 2);
#pragma unroll
            for (int jt = 0; jt < 4; ++jt) {
                f32x4 gx = (f32x4){0.f, 0.f, 0.f, 0.f}, ga = gx;
#pragma unroll
                for (int ks = 0; ks < 2; ++ks) {
                    const bf16x8 wxa = *(const LAS bf16x8*)(WX + (16 * jt + n16) * XBB + (32 * ks + 8 * g) * 2);
                    const bf16x8 waa = *(const LAS bf16x8*)(WA + (16 * jt + n16) * XBB + (32 * ks + 8 * g) * 2);
                    gx = MFMA16(wxa, xb[ks], gx); ga = MFMA16(waa, xb[ks], ga);
                }
                const int j0 = 16 * jt + 4 * g;
                const f32x4 bxv = *(const LAS f32x4*)(BX + j0), bav = *(const LAS f32x4*)(BA + j0), spv = *(const LAS f32x4*)(SP + j0);
                f32x4 av, uv;
#pragma unroll
                for (int r = 0; r < 4; ++r) {
                    const float it = sigm(gx[r] + bxv[r]), rt = sigm(ga[r] + bav[r]);
                    const float la = -8.0f * rt * spv[r];
                    const float aa = __expf(la);
                    av[r] = aa;
                    uv[r] = __builtin_amdgcn_sqrtf(fmaxf(1.0f - aa * aa, 0.f)) * (it * xcv[jt][r]);
                }
                *(LAS f32x4*)(AF + trow * XS + j0) = av; *(LAS f32x4*)(UF + trow * XS + j0) = uv;
            }
        }
        __builtin_amdgcn_wave_barrier();
        float hl[16], ac[16], sg[16];
        {
            float hh = 0.f, aa = 1.f;
#pragma unroll
            for (int s = 0; s < 16; ++s) { const float a = AF[(16 * w + s) * XS + lane], u = UF[(16 * w + s) * XS + lane]; hh = a * hh + u; aa *= a; hl[s] = hh; ac[s] = aa; }
            SEG0[(tt & 1) * 512 + w * 64 + lane] = (f32x2){aa, hh};
#pragma unroll
            for (int s = 0; s < 16; ++s) { const float gv_ = bf1(*(const LAS bf16_t*)(SG + (16 * w + s) * SGB + lane * 2)); sg[s] = gv_ * sigm(gv_); }
        }
        __syncthreads();
        if (tt + 1 < 16) { LRU_STAGE(); if (tt + 2 < 16) LRU_LOAD(t0 + 256); }
        float hin = 0.f;
        {
            float hc = state;
#pragma unroll
            for (int s2 = 0; s2 < 8; ++s2) { if (s2 == w) hin = hc; const f32x2 sv = SEG0[(tt & 1) * 512 + s2 * 64 + lane]; hc = sv.x * hc + sv.y; }
            state = hc;
        }
#pragma unroll
        for (int s = 0; s < 16; ++s) { const float ht = hl[s] + ac[s] * hin; gyb[(size_t)(t0 + 16 * w + s) * D_ + lane] = (bf16_t)f2bf(sg[s] * ht); }
        gn_row_finish(gnr, gnv, GB, gn_row0 + tt * gn_stride, lane);
        __builtin_amdgcn_wave_barrier();
    }
#undef LRU_LOAD
#undef LRU_STAGE
}

#define XB_TMO      128
#define XB_XCNT(j)  (256  + 64 * (j))
#define XB_XSUB(j)  (1280 + 64 * (j))
#define XB_XGEN(j)  (2304 + 64 * (j))
#define XB_TOP      3328
#define XB_TOPGEN   3392
#define XCD_BAR_WORDS 3456
#define XB_SPIN_CAP (1u << 18)

__device__ __forceinline__ unsigned xb_ld(unsigned* p)              { return __hip_atomic_load(p, __ATOMIC_RELAXED, __HIP_MEMORY_SCOPE_AGENT); }
__device__ __forceinline__ unsigned xb_add(unsigned* p, unsigned v) { return __hip_atomic_fetch_add(p, v, __ATOMIC_RELAXED, __HIP_MEMORY_SCOPE_AGENT); }
__device__ __forceinline__ unsigned xb_xcc_id() { return (unsigned)__builtin_amdgcn_s_getreg((3 << 11) | 20) & 0xFu; }
#define XB_SPIN(cond, bar) do { unsigned _sp = 0; while (cond) { __builtin_amdgcn_s_sleep(1); \
    if ((++_sp & 255u) == 0u) { if (xb_ld(&(bar)[XB_TMO])) break; if (_sp > XB_SPIN_CAP) { atomicAdd(&(bar)[XB_TMO], 1u); break; } } } } while (0)

struct XcdBarrier {
    unsigned* bar; unsigned x;
    volatile LAS unsigned* st;
};

__device__ __forceinline__ XcdBarrier xcd_barrier_post(unsigned* bar, volatile LAS unsigned* st) {
    XcdBarrier b; b.bar = bar; b.x = xb_xcc_id(); b.st = st;
    if (threadIdx.x == 0) (void)xb_add(&bar[XB_XCNT(b.x)], 1u);
    return b;
}
__device__ __forceinline__ void xcd_barrier_complete(unsigned* bar, unsigned x, unsigned& nloc, unsigned& nx) {
    const unsigned G = gridDim.x * gridDim.y * gridDim.z;
    unsigned sum, cnt, mine, sp = 0u;
    for (;;) {
        sum = 0u; cnt = 0u; mine = 0u;
#pragma unroll
        for (unsigned j = 0; j < 16; ++j) { const unsigned c = xb_ld(&bar[XB_XCNT(j)]); sum += c; cnt += (c > 0u) ? 1u : 0u; mine = (j == x) ? c : mine; }
        if (sum == G) break;
        __builtin_amdgcn_s_sleep(1);
        if ((++sp & 255u) == 0u) { if (xb_ld(&bar[XB_TMO])) break; if (sp > XB_SPIN_CAP) { atomicAdd(&bar[XB_TMO], 1u); break; } }
    }
    nloc = mine > 0u ? mine : 1u; nx = cnt > 0u ? cnt : 1u;
}

__device__ __forceinline__ void xcd_barrier(const XcdBarrier& b) {
    asm volatile("s_waitcnt vmcnt(0)" ::: "memory");
    __syncthreads();
    if (threadIdx.x == 0) {
        unsigned* bar = b.bar;
        __builtin_amdgcn_s_waitcnt(0);
        unsigned nloc = b.st[0], nx = b.st[1];
        if (nloc == 0u) { xcd_barrier_complete(bar, b.x, nloc, nx); b.st[0] = nloc; b.st[1] = nx; }
        const unsigned old = xb_add(&bar[XB_XSUB(b.x)], 1u);
        const unsigned gen = old / nloc;
        if (old + 1u == (gen + 1u) * nloc) {
            __builtin_amdgcn_fence(__ATOMIC_RELEASE, "agent");
            asm volatile("s_waitcnt vmcnt(0)" ::: "memory");
            const unsigned og = xb_add(&bar[XB_TOP], 1u);
            const unsigned tg = og / nx;
            if (og + 1u == (tg + 1u) * nx) xb_add(&bar[XB_TOPGEN], 1u);
            else XB_SPIN(xb_ld(&bar[XB_TOPGEN]) == tg, bar);
            __builtin_amdgcn_fence(__ATOMIC_ACQUIRE, "agent");
            xb_add(&bar[XB_XGEN(b.x)], 1u);
            asm volatile("s_waitcnt vmcnt(0)" ::: "memory");
        } else {
            XB_SPIN(xb_ld(&bar[XB_XGEN(b.x)]) == gen, bar);
            __builtin_amdgcn_fence(__ATOMIC_ACQUIRE, "agent");
            asm volatile("s_waitcnt vmcnt(0)" ::: "memory");
        }
    }
    __syncthreads();
}

struct Args { const float* in[15]; float* out; unsigned char* ws; int never, pad; };
__global__ void __launch_bounds__(512) mega_fwd(Args a) {
    extern __shared__ __attribute__((aligned(16))) unsigned char lds_raw[];
    LAS unsigned char* lds = (LAS unsigned char*)lds_raw;
    cg::grid_group grid = cg::this_grid();
#define SEAM() xcd_barrier(xbar)
#define RUN(k) if (a.never != 100 + (k))
    unsigned char* ws = a.ws;
    bf16_t* WinT = (bf16_t*)(ws + WS_WIN); bf16_t* WpaT = (bf16_t*)(ws + WS_WPA); bf16_t* WpbT = (bf16_t*)(ws + WS_WPB); bf16_t* WoutT = (bf16_t*)(ws + WS_WOUT);
    float* cosT = (float*)(ws + WS_COS); float* sinT = (float*)(ws + WS_SIN); f32x2* stats = (f32x2*)(ws + WS_STAT);
    bf16_t* seg0 = (bf16_t*)(ws + WS_SEG0);
    bf16_t* XA = seg0; bf16_t* GY = seg0 + SEG_ELEMS; bf16_t* Qb = seg0 + 2 * SEG_ELEMS; bf16_t* Kb = seg0 + 3 * SEG_ELEMS; bf16_t* Vb = seg0 + 4 * SEG_ELEMS;
    bf16_t* GB = seg0 + 5 * SEG_ELEMS; bf16_t* MA = seg0 + 6 * SEG_ELEMS; bf16_t* MRG = seg0;
    bf16_t* H = (bf16_t*)a.out; bf16_t* Oraw = (bf16_t*)a.out; bf16_t* MB = (bf16_t*)a.out + SEG_ELEMS;
    const int G = gridDim.x;
    volatile LAS unsigned* xst = (volatile LAS unsigned*)(lds + LDS_BYTES - 64);
    if (threadIdx.x < 2) xst[threadIdx.x] = 0u;
    __syncthreads();
    const XcdBarrier xbar = xcd_barrier_post((unsigned*)(ws + WS_CTL), xst);

    RUN(0) p0_prologue(lds, a.in[0], a.in[1], a.in[2], a.in[11], a.in[12], a.in[13], WinT, WpaT, WpbT, WoutT, H, cosT, sinT);
    SEAM();
    RUN(1) {
        pg8::Gemm gm{H, WinT, T_, NCOL_, D_}; pg8::StaticOrder S; S.init(T_, NCOL_, G, (int)blockIdx.x);
        EpiProj E{seg0, MB, cosT, sinT};
        pg8::gemm_phase<EpiProj, pg8::StaticOrder, true, true>(lds, gm, S, E);
    }
    SEAM();
    RUN(2) for (int it = blockIdx.x; it < 256; it += G) { const int xcd = it & 7, slot = it >> 3; ret_item(lds, (((slot >> 2) * 8 + xcd) << 2) | (slot & 3), Qb, Kb, Vb, Oraw, stats); }
    SEAM();
    RUN(3) lru_item(lds, (int)blockIdx.x, XA, GY, a.in[3], a.in[4], a.in[5], a.in[6], a.in[7], a.in[8], a.in[9], Oraw, stats, a.in[10], GB, (int)blockIdx.x * 8 + (int)(threadIdx.x >> 6), G * 8);
    SEAM();
    RUN(4) {
    __syncthreads();
    { pg8::Gemm gm{GY, WpaT, T_, D_, D_}; pg8::StaticOrder S; S.init(T_, D_, G, (int)blockIdx.x); EpiGate<0> E{MA, MRG};
      pg8::gemm_phase<EpiGate<0>, pg8::StaticOrder, true, true>(lds, gm, S, E); }
    { pg8::Gemm gm{GB, WpbT, T_, D_, D_}; pg8::StaticOrder S; S.init(T_, D_, G, (int)blockIdx.x); EpiGate<1> E{MB, MRG};
      pg8::gemm_phase<EpiGate<1>, pg8::StaticOrder, true, true>(lds, gm, S, E); }
    }
    SEAM();
#define OUT_HALF(r) do { const size_t roff = (size_t)(r) * 16384 * D_; \
        pg8::Gemm gm{MRG + roff, WoutT, 16384, D_, D_}; pg8::StaticOrder S; S.init(16384, D_, G, (int)blockIdx.x); \
        EpiResidNorm E{a.in[0] + roff, a.out + roff, a.in[14], (float*)(ws + WS_XSLOT) + (size_t)(r) * 16384 * 4, (unsigned*)(ws + WS_CTL + 16384) + (r) * 64 * 64}; \
        pg8::gemm_phase<EpiResidNorm, pg8::StaticOrder, false, true>(lds, gm, S, E); } while (0)
    RUN(5) { OUT_HALF(0); OUT_HALF(1); }
#undef OUT_HALF
    if (a.never == 0x7fffffff) grid.sync();
#undef SEAM
#undef RUN
}

extern "C" void kernel_launch(void* const* d_in, const int* in_sizes, int n_in, void* d_out, int out_size, void* d_ws, size_t ws_size, hipStream_t stream) {
    static int ready = 0;
    if (ready == 0) {
        ready = 1;
        if (n_in != 15 || out_size != T_ * D_ || ws_size < WS_END) { fprintf(stderr, "kernel_launch: built for 15 inputs, %d outputs, >= %zu B of workspace (got %d, %d, %zu)\n", T_ * D_, (size_t)WS_END, n_in, out_size, ws_size); ready = -1; }
        else if (hipFuncSetAttribute((const void*)mega_fwd, hipFuncAttributeMaxDynamicSharedMemorySize, LDS_BYTES) != hipSuccess) { fprintf(stderr, "kernel_launch: hipFuncSetAttribute failed\n"); ready = -1; }
    }
    if (ready < 0) return;
    if (hipMemsetAsync((char*)d_ws + WS_CTL, 0, CTL_BYTES, stream) != hipSuccess) { fprintf(stderr, "kernel_launch: hipMemsetAsync failed\n"); return; }
    Args a{};
    for (int i = 0; i < 15; ++i) a.in[i] = (const float*)d_in[i];
    a.out = (float*)d_out; a.ws = (unsigned char*)d_ws;
    void* args[] = {&a};
    hipError_t e = hipLaunchCooperativeKernel((const void*)mega_fwd, dim3(256), dim3(512), args, LDS_BYTES, stream);
    if (e != hipSuccess) fprintf(stderr, "cooperative launch failed: %s\n", hipGetErrorString(e));
}
```

```cpp
#include <hip/hip_runtime.h>
#include <hip/hip_cooperative_groups.h>
#include <cstdio>
#include <cstdint>
namespace cg = cooperative_groups;
namespace pg8 {
#define PG8_LAS __attribute__((address_space(3)))
typedef unsigned short bf16_t;
typedef short bf16x8 __attribute__((ext_vector_type(8)));
typedef float f32x4 __attribute__((ext_vector_type(4)));
typedef unsigned u32x4 __attribute__((ext_vector_type(4)));
constexpr int BM = 256, BK = 64, HALF = 128, HTB = HALF * BK * 2  , STAGE_BYTES = 8 * HTB, NXCD = 8, WGM = 8;

__host__ __device__ __forceinline__ int lds_byte(int r, int c) { const int st = (r >> 4) * 2 + (c >> 5), rr = r & 15, cc = c & 31, ob = rr * 64 + cc * 2; return st * 1024 + (ob ^ (((ob >> 9) & 1) << 5)); }
__host__ __device__ __forceinline__ void stage_rc(int b, int& R, int& C) { const int st = b / 1024, sb = b % 1024, swz = sb ^ (((sb >> 9) & 1) << 5); R = (st >> 1) * 16 + swz / 64; C = (st & 1) * 32 + (swz % 64) / 2; }
__host__ __device__ __forceinline__ int perm32(int rho) { const int n = rho >> 4, i = rho & 15; return 8 * (i >> 2) + 4 * n + (i & 3); }

struct Unit { int pm, pn; };
struct Gemm { const bf16_t* A; const bf16_t* Bt; int M, N, K; };

struct StaticOrder {
    int nM, nN, nwg, G, c;
    __host__ __device__ void init(int M, int N, int G_, int c_) { nM = M / BM; nN = N / BM; nwg = nM * nN; G = G_; c = c_; }
    __host__ __device__ bool next(int i, Unit& u) const {
        const long L = (long)i * G + c; if (L >= nwg) return false;
        int wgid = (int)L; { const int q = nwg / NXCD, r = nwg % NXCD, xcd = wgid % NXCD, off = wgid / NXCD; wgid = (xcd < r ? xcd * (q + 1) : r * (q + 1) + (xcd - r) * q) + off; }
        const int nig = WGM * nN, gid = wgid / nig, fm = gid * WGM, gsz = (nM - fm) < WGM ? (nM - fm) : WGM;
        u.pm = fm + ((wgid % nig) % gsz); u.pn = (wgid % nig) / gsz; return true;
    }
    __device__ __forceinline__ void a_ready(const Unit&) const {}
    __device__ __forceinline__ void done(const Unit&) const {}
};
typedef __bf16 bf16x2_cv __attribute__((ext_vector_type(2)));
typedef float f32x2_cv __attribute__((ext_vector_type(2)));
__device__ __forceinline__ unsigned cvt_pk_bf16(float lo, float hi) { const f32x2_cv v = {lo, hi}; return __builtin_bit_cast(unsigned, __builtin_convertvector(v, bf16x2_cv)); }
template <class Epi, class Sched, bool ALIGN_EPI = false, bool SP2 = false>
__device__ __forceinline__ void gemm_phase(PG8_LAS unsigned char* lds, const Gemm g, const Sched& S, const Epi& E) {
    const int tid = threadIdx.x, wid = __builtin_amdgcn_readfirstlane(tid >> 6), lane = tid & 63, wr = wid >> 2, wc = wid & 3, fr = lane & 15, fq = lane >> 4;
    const int K = g.K, nt = K / BK;
    unsigned voffA[2], voffB[2];
#pragma unroll
    for (int i = 0; i < 2; ++i) { int R, C; stage_rc(tid * 16 + i * 8192, R, C); const int Rb = Epi::PERM ? ((R & ~31) + perm32(R & 31)) : R;
        voffA[i] = (unsigned)(R * K + C) * 2u; voffB[i] = (unsigned)(Rb * K + C) * 2u; }
    const size_t kstep = (size_t)(BK * 2);
    const size_t hstep = (size_t)HALF * K * 2;
    const size_t tstep = 2 * hstep;
    const unsigned ldsw = (unsigned)wid * 1024u;
    const int aoff = lds_byte(wr * 64 + fr, fq * 8), boff = lds_byte(wc * 32 + fr, fq * 8);
#define PG8_SA(b, h) (((b) * 2 + (h)) * HTB)
#define PG8_SB(b, h) ((4 + (b) * 2 + (h)) * HTB)
#define PG8_STAGE(bufoff, gbase, voff) do { _Pragma("unroll") for (int _i = 0; _i < 2; ++_i) \
        __builtin_amdgcn_global_load_lds((const unsigned*)((const char*)(gbase) + (voff)[_i]), (PG8_LAS unsigned*)(lds + (bufoff) + ldsw + _i * 8192), 16, 0, 0); } while (0)
#define PG8_LDA(dst, b, h) do { _Pragma("unroll") for (int m = 0; m < 4; ++m) _Pragma("unroll") for (int k = 0; k < 2; ++k) dst[m][k] = *(const PG8_LAS bf16x8*)(lds + PG8_SA(b, h) + aoff + m * 2048 + k * 1024); } while (0)
#define PG8_LDB(dst, b, h) do { _Pragma("unroll") for (int n = 0; n < 2; ++n) _Pragma("unroll") for (int k = 0; k < 2; ++k) dst[n][k] = *(const PG8_LAS bf16x8*)(lds + PG8_SB(b, h) + boff + n * 2048 + k * 1024); } while (0)
#define PG8_MMA(ai, bj, At, Bt) do { __builtin_amdgcn_s_setprio(1); _Pragma("unroll") for (int m = 0; m < 4; ++m) _Pragma("unroll") for (int n = 0; n < 2; ++n) _Pragma("unroll") for (int k = 0; k < 2; ++k) \
        acc[ai][bj][m][n] = __builtin_amdgcn_mfma_f32_16x16x32_bf16(Bt[n][k], At[m][k], acc[ai][bj][m][n], 0, 0, 0); __builtin_amdgcn_s_setprio(0); } while (0)
#define PG8_WAIT_V(n) asm volatile("s_waitcnt vmcnt(" #n ")" ::: "memory")
#define PG8_WAIT_L(n) asm volatile("s_waitcnt lgkmcnt(" #n ")" ::: "memory")
#define PG8_BAR __builtin_amdgcn_s_barrier()
#define PG8_SCHED __builtin_amdgcn_sched_barrier(0)
    Unit cur, nxt; int ui = 0;
    if (!S.next(0, cur)) return;
    f32x4 acc[2][2][4][2];
#pragma unroll
    for (int a = 0; a < 2; ++a)
#pragma unroll
        for (int b = 0; b < 2; ++b)
#pragma unroll
            for (int m = 0; m < 4; ++m)
#pragma unroll
                for (int n = 0; n < 2; ++n) acc[a][b][m][n] = (f32x4){0.f, 0.f, 0.f, 0.f};
    bf16x8 At[4][2], B0[2][2], B1[2][2];
    const char* cA = (const char*)g.A + (size_t)cur.pm * tstep; const char* cB = (const char*)g.Bt + (size_t)cur.pn * tstep;
    S.a_ready(cur);
    if constexpr (SP2) {
        PG8_STAGE(PG8_SB(0, 0), cB, voffB); PG8_STAGE(PG8_SB(0, 1), cB + hstep, voffB); PG8_STAGE(PG8_SA(0, 0), cA, voffA); PG8_STAGE(PG8_SA(0, 1), cA + hstep, voffA);
        if (wr == 1) PG8_BAR;
        PG8_WAIT_V(2); PG8_BAR;
        PG8_STAGE(PG8_SB(1, 0), cB + kstep, voffB); PG8_STAGE(PG8_SA(1, 0), cA + kstep, voffA); PG8_STAGE(PG8_SB(1, 1), cB + hstep + kstep, voffB);
        PG8_WAIT_V(6); PG8_BAR;
    } else {
        PG8_STAGE(PG8_SB(0, 0), cB, voffB); PG8_STAGE(PG8_SA(0, 0), cA, voffA); PG8_STAGE(PG8_SB(0, 1), cB + hstep, voffB); PG8_STAGE(PG8_SA(0, 1), cA + hstep, voffA);
        if (wr == 1) PG8_BAR;
        PG8_WAIT_V(4); PG8_BAR;
        PG8_STAGE(PG8_SB(1, 0), cB + kstep, voffB); PG8_STAGE(PG8_SA(1, 0), cA + kstep, voffA); PG8_STAGE(PG8_SB(1, 1), cB + hstep + kstep, voffB);
        PG8_WAIT_V(6); PG8_BAR;
    }
    for (;;) {
        const bool has_next = S.next(ui + 1, nxt);
        const char* nA = has_next ? (const char*)g.A + (size_t)nxt.pm * tstep : cA; const char* nB = has_next ? (const char*)g.Bt + (size_t)nxt.pn * tstep : cB;
        for (int t = 0; t < nt; t += 2) {
            const bool last = (t == nt - 2);
            const char* a1 = cA + (size_t)(t + 1) * kstep;
            const char* a2 = last ? nA : cA + (size_t)(t + 2) * kstep; const char* b2 = last ? nB : cB + (size_t)(t + 2) * kstep;
            const char* a3 = a2 + kstep; const char* b3 = b2 + kstep;
            if (last && has_next) S.a_ready(nxt);
            if constexpr (SP2) {
            PG8_LDB(B0, 0, 0); PG8_LDB(B1, 0, 1); PG8_SCHED; PG8_LDA(At, 0, 0); PG8_STAGE(PG8_SA(1, 1), a1 + hstep, voffA);
            PG8_WAIT_V(8); PG8_WAIT_L(0); PG8_BAR; PG8_MMA(0, 0, At, B0); PG8_MMA(0, 1, At, B1); PG8_BAR; PG8_SCHED;
            PG8_LDA(At, 0, 1); PG8_STAGE(PG8_SB(0, 0), b2, voffB); PG8_STAGE(PG8_SB(0, 1), b2 + hstep, voffB); PG8_STAGE(PG8_SA(0, 0), a2, voffA);
            PG8_WAIT_V(8); PG8_WAIT_L(0); PG8_BAR; PG8_MMA(1, 0, At, B0); PG8_MMA(1, 1, At, B1); PG8_BAR; PG8_SCHED;
            PG8_LDB(B0, 1, 0); PG8_LDB(B1, 1, 1); PG8_SCHED; PG8_LDA(At, 1, 0); PG8_STAGE(PG8_SA(0, 1), a2 + hstep, voffA);
            PG8_WAIT_V(8); PG8_WAIT_L(0); PG8_BAR; PG8_MMA(0, 0, At, B0); PG8_MMA(0, 1, At, B1); PG8_BAR; PG8_SCHED;
            PG8_LDA(At, 1, 1); PG8_STAGE(PG8_SB(1, 0), b3, voffB); PG8_STAGE(PG8_SB(1, 1), b3 + hstep, voffB); PG8_STAGE(PG8_SA(1, 0), a3, voffA);
            PG8_WAIT_V(8); PG8_WAIT_L(0); PG8_BAR; PG8_MMA(1, 0, At, B0); PG8_MMA(1, 1, At, B1); PG8_BAR; PG8_SCHED;
            } else {
            PG8_LDB(B0, 0, 0); PG8_SCHED; PG8_LDA(At, 0, 0); PG8_STAGE(PG8_SA(1, 1), a1 + hstep, voffA);
            PG8_WAIT_L(8); PG8_BAR; PG8_WAIT_L(0); PG8_MMA(0, 0, At, B0); PG8_BAR; PG8_SCHED;
            PG8_LDB(B1, 0, 1); PG8_STAGE(PG8_SB(0, 0), b2, voffB);
            PG8_BAR; PG8_WAIT_L(0); PG8_MMA(0, 1, At, B1); PG8_BAR;
            PG8_LDA(At, 0, 1); PG8_STAGE(PG8_SA(0, 0), a2, voffA);
            PG8_BAR; PG8_WAIT_L(0); PG8_MMA(1, 0, At, B0); PG8_BAR; PG8_SCHED;
            PG8_STAGE(PG8_SB(0, 1), b2 + hstep, voffB);
            PG8_WAIT_V(6); PG8_BAR; PG8_MMA(1, 1, At, B1); PG8_BAR;
            PG8_LDB(B0, 1, 0); PG8_SCHED; PG8_LDA(At, 1, 0); PG8_STAGE(PG8_SA(0, 1), a2 + hstep, voffA);
            PG8_WAIT_L(8); PG8_BAR; PG8_WAIT_L(0); PG8_MMA(0, 0, At, B0); PG8_BAR; PG8_SCHED;
            PG8_LDB(B1, 1, 1); PG8_STAGE(PG8_SB(1, 0), b3, voffB);
            PG8_BAR; PG8_WAIT_L(0); PG8_MMA(0, 1, At, B1); PG8_BAR;
            PG8_LDA(At, 1, 1); PG8_STAGE(PG8_SA(1, 0), a3, voffA);
            PG8_BAR; PG8_WAIT_L(0); PG8_MMA(1, 0, At, B0); PG8_BAR; PG8_SCHED;
            PG8_STAGE(PG8_SB(1, 1), b3 + hstep, voffB);
            PG8_WAIT_V(6); PG8_BAR; PG8_MMA(1, 1, At, B1); PG8_BAR;
            }
        }
        if constexpr (ALIGN_EPI) { if (wr == 0) PG8_BAR; }
        if constexpr (!Epi::AFTER_DRAIN) { E(acc, cur, wr, wc, fr, fq); S.done(cur); }
        if (!has_next) break;
#pragma unroll
        for (int a = 0; a < 2; ++a)
#pragma unroll
            for (int b = 0; b < 2; ++b)
#pragma unroll
                for (int m = 0; m < 4; ++m)
#pragma unroll
                    for (int n = 0; n < 2; ++n) acc[a][b][m][n] = (f32x4){0.f, 0.f, 0.f, 0.f};
        cur = nxt; cA = nA; cB = nB; ++ui;
        if constexpr (ALIGN_EPI) { if (wr == 1) PG8_BAR; }
    }
    PG8_WAIT_V(0);
    if constexpr (!ALIGN_EPI) { if (wr == 0) PG8_BAR; }
    PG8_BAR;
    if constexpr (Epi::AFTER_DRAIN) { E.fused(acc, cur, wr, wc, fr, fq, lds, wid, lane); S.done(cur); }
#undef PG8_SA
#undef PG8_SB
#undef PG8_STAGE
#undef PG8_LDA
#undef PG8_LDB
#undef PG8_MMA
#undef PG8_WAIT_V
#undef PG8_WAIT_L
#undef PG8_BAR
#undef PG8_SCHED
}
}
#define LAS __attribute__((address_space(3)))
typedef unsigned short bf16_t;
typedef short bf16x8 __attribute__((ext_vector_type(8)));
typedef short s16x4 __attribute__((ext_vector_type(4)));
typedef float f32x4 __attribute__((ext_vector_type(4)));
typedef float f32x2 __attribute__((ext_vector_type(2)));
typedef unsigned u32x4 __attribute__((ext_vector_type(4)));
typedef unsigned u32x2 __attribute__((ext_vector_type(2)));

constexpr int T_ = 32768, D_ = 1024, S_ = 2048, NB_ = 16, NCOL_ = 8192;
constexpr float EPS_ = 1e-6f;
constexpr size_t MiB = 1u << 20;
constexpr size_t WS_WIN = 0, WS_WPA = 16 * MiB, WS_WPB = 18 * MiB, WS_WOUT = 20 * MiB;
constexpr size_t WS_COS = 22 * MiB, WS_SIN = 23 * MiB, WS_STAT = 24 * MiB, WS_SSQ = 28 * MiB;
constexpr size_t WS_CTL = 30 * MiB, WS_XSLOT = WS_CTL + 16384, CTL_BYTES = 16384 + (size_t)T_ * 4 * 8;
constexpr size_t WS_SEG0 = 32 * MiB, SEG_BYTES = 64 * MiB, SEG_ELEMS = SEG_BYTES / 2;
constexpr size_t WS_END = WS_SEG0 + 7 * SEG_BYTES;
constexpr int LDS_BYTES = 152 * 1024;

__device__ __forceinline__ unsigned f2bf(float f) { unsigned u = __builtin_bit_cast(unsigned, f); return (u + 0x7fffu + ((u >> 16) & 1u)) >> 16; }
__device__ __forceinline__ unsigned pk2(float lo, float hi) { return pg8::cvt_pk_bf16(lo, hi); }
__device__ __forceinline__ float bf_lo(unsigned w) { return __builtin_bit_cast(float, w << 16); }
__device__ __forceinline__ float bf_hi(unsigned w) { return __builtin_bit_cast(float, w & 0xffff0000u); }
__device__ __forceinline__ float bf1(bf16_t b) { return __builtin_bit_cast(float, ((unsigned)b) << 16); }
__device__ __forceinline__ float sigm(float x) { return __builtin_amdgcn_rcpf(1.0f + __expf(-x)); }
__device__ __forceinline__ float wave_sum(float v) {
#pragma unroll
    for (int o = 1; o < 64; o <<= 1) v += __shfl_xor(v, o);
    return v;
}

struct EpiProj {
    static constexpr bool PERM = true, AFTER_DRAIN = false;
    bf16_t* seg0; bf16_t* mbp; const float* cosT; const float* sinT;
    __device__ __forceinline__ void operator()(const f32x4 (&acc)[2][2][4][2], const pg8::Unit& u, int wr, int wc, int fr, int fq) const {
        const int seg = u.pn >> 2, ct = (u.pn & 3) * 256;
        bf16_t* base = (seg == 7) ? mbp : seg0 + (size_t)seg * SEG_ELEMS;
        const int row0 = u.pm * 256 + wr * 64 + fr, col0 = ct + wc * 32 + 8 * fq;
        if (seg == 2 || seg == 3) {
            const int hh = u.pn & 3;
            const float lg = log2f(1.0f - exp2f(-5.0f - (float)hh));
            const int j0 = wc * 32 + 8 * fq;
#pragma unroll
            for (int ai = 0; ai < 2; ++ai)
#pragma unroll
                for (int m = 0; m < 4; ++m) {
                    const int row = row0 + ai * 128 + m * 16, s = row & (S_ - 1);
                    const float jj = (float)(s & 127);
                    const float sc = (seg == 2) ? exp2f(jj * lg) : exp2f(-jj * lg) * 0.0625f;
                    const f32x4 c0 = *(const f32x4*)(cosT + s * 128 + j0), c1 = *(const f32x4*)(cosT + s * 128 + j0 + 4);
                    const f32x4 s0 = *(const f32x4*)(sinT + s * 128 + j0), s1 = *(const f32x4*)(sinT + s * 128 + j0 + 4);
                    const f32x4 x10 = acc[ai][0][m][0], x11 = acc[ai][0][m][1], x20 = acc[ai][1][m][0], x21 = acc[ai][1][m][1];
                    const f32x4 y10 = (x10 * c0 - x20 * s0) * sc, y11 = (x11 * c1 - x21 * s1) * sc;
                    const f32x4 y20 = (x10 * s0 + x20 * c0) * sc, y21 = (x11 * s1 + x21 * c1) * sc;
                    bf16_t* rowp = base + (size_t)row * D_ + col0;
                    u32x4 w1, w2;
                    w1.x = pk2(y10[0], y10[1]); w1.y = pk2(y10[2], y10[3]); w1.z = pk2(y11[0], y11[1]); w1.w = pk2(y11[2], y11[3]);
                    w2.x = pk2(y20[0], y20[1]); w2.y = pk2(y20[2], y20[3]); w2.z = pk2(y21[0], y21[1]); w2.w = pk2(y21[2], y21[3]);
                    __builtin_nontemporal_store(w1, (u32x4*)(rowp)); __builtin_nontemporal_store(w2, (u32x4*)(rowp + 128));
                }
        } else {
            const int act = (seg >= 6) ? 2 : 0;
#pragma unroll
            for (int ai = 0; ai < 2; ++ai)
#pragma unroll
                for (int m = 0; m < 4; ++m) {
                    bf16_t* rowp = base + (size_t)(row0 + ai * 128 + m * 16) * D_ + col0;
#pragma unroll
                    for (int bj = 0; bj < 2; ++bj) {
                        f32x4 v0 = acc[ai][bj][m][0], v1 = acc[ai][bj][m][1];
                        if (act) {
#pragma unroll
                            for (int e = 0; e < 4; ++e) {
                                const float g0 = sigm(v0[e]), g1 = sigm(v1[e]);
                                v0[e] = (act == 1) ? v0[e] * g0 : g0; v1[e] = (act == 1) ? v1[e] * g1 : g1;
                            }
                        }
                        u32x4 w; w.x = pk2(v0[0], v0[1]); w.y = pk2(v0[2], v0[3]); w.z = pk2(v1[0], v1[1]); w.w = pk2(v1[2], v1[3]);
                        __builtin_nontemporal_store(w, (u32x4*)(rowp + bj * 128));
                    }
                }
        }
    }
};
template <int MODE> struct EpiGate {
    static constexpr bool PERM = true, AFTER_DRAIN = false;
    const bf16_t* gate; bf16_t* out;
    __device__ __forceinline__ void operator()(const f32x4 (&acc)[2][2][4][2], const pg8::Unit& u, int wr, int wc, int fr, int fq) const {
        const int row0 = u.pm * 256 + wr * 64 + fr, col0 = u.pn * 256 + wc * 32 + 8 * fq;
#pragma unroll
        for (int ai = 0; ai < 2; ++ai)
#pragma unroll
            for (int m = 0; m < 4; ++m)
#pragma unroll
                for (int bj = 0; bj < 2; ++bj) {
                    const size_t off = (size_t)(row0 + ai * 128 + m * 16) * D_ + col0 + bj * 128;
                    const u32x4 gv = *(const u32x4*)(gate + off);
                    f32x4 v0 = acc[ai][bj][m][0], v1 = acc[ai][bj][m][1];
                    v0[0] *= bf_lo(gv.x); v0[1] *= bf_hi(gv.x); v0[2] *= bf_lo(gv.y); v0[3] *= bf_hi(gv.y);
                    v1[0] *= bf_lo(gv.z); v1[1] *= bf_hi(gv.z); v1[2] *= bf_lo(gv.w); v1[3] *= bf_hi(gv.w);
                    if (MODE == 1) {
                        const u32x4 pv = *(const u32x4*)(out + off);
                        v0[0] += bf_lo(pv.x); v0[1] += bf_hi(pv.x); v0[2] += bf_lo(pv.y); v0[3] += bf_hi(pv.y);
                        v1[0] += bf_lo(pv.z); v1[1] += bf_hi(pv.z); v1[2] += bf_lo(pv.w); v1[3] += bf_hi(pv.w);
                    }
                    u32x4 w; w.x = pk2(v0[0], v0[1]); w.y = pk2(v0[2], v0[3]); w.z = pk2(v1[0], v1[1]); w.w = pk2(v1[2], v1[3]);
                    *(u32x4*)(out + off) = w;
                }
    }
};
struct EpiResid {
    static constexpr bool PERM = false, AFTER_DRAIN = false;
    const float* x; bf16_t* out; float* ssq;
    __device__ __forceinline__ void operator()(const f32x4 (&acc)[2][2][4][2], const pg8::Unit& u, int wr, int wc, int fr, int fq) const {
        const int row0 = u.pm * 256 + wr * 64 + fr, col0 = u.pn * 256 + wc * 32 + 4 * fq;
#pragma unroll
        for (int ai = 0; ai < 2; ++ai)
#pragma unroll
            for (int m = 0; m < 4; ++m) {
                const int row = row0 + ai * 128 + m * 16; float q = 0.f;
#pragma unroll
                for (int bj = 0; bj < 2; ++bj)
#pragma unroll
                    for (int n = 0; n < 2; ++n) {
                        const size_t off = (size_t)row * D_ + col0 + bj * 128 + n * 16;
                        const f32x4 o = *(const f32x4*)(x + off) + acc[ai][bj][m][n];
                        u32x2 pkd; pkd.x = pk2(o[0], o[1]); pkd.y = pk2(o[2], o[3]);
                        *(u32x2*)(out + off) = pkd;
                        q += (o[0] * o[0] + o[1] * o[1]) + (o[2] * o[2] + o[3] * o[3]);
                    }
                q += __shfl_xor(q, 16); q += __shfl_xor(q, 32);
                if (fq == 0) ssq[(size_t)(u.pn * 4 + wc) * T_ + row] = q;
            }
    }
};


struct EpiResidNorm {
    static constexpr bool PERM = false, AFTER_DRAIN = true;
    const float* x; float* out; const float* gfin; unsigned long long* xslots;
    __device__ __forceinline__ void fused(f32x4 (&acc)[2][2][4][2], const pg8::Unit& u, int wr, int wc, int fr, int fq, LAS unsigned char* lds, int wid, int lane) const {
        LAS float* P = (LAS float*)lds;
        LAS float* Srs = (LAS float*)(lds + 4096);
        const int row0 = u.pm * 256 + wr * 64 + fr, col0 = u.pn * 256 + wc * 32 + 4 * fq;
#pragma unroll
        for (int ai = 0; ai < 2; ++ai)
#pragma unroll
            for (int m = 0; m < 4; ++m) {
                const size_t rbase = (size_t)(row0 + ai * 128 + m * 16) * D_ + col0; float q = 0.f;
#pragma unroll
                for (int bj = 0; bj < 2; ++bj)
#pragma unroll
                    for (int n = 0; n < 2; ++n) {
                        const f32x4 o = *(const f32x4*)(x + rbase + bj * 128 + n * 16) + acc[ai][bj][m][n];
                        acc[ai][bj][m][n] = o;
                        q += (o[0] * o[0] + o[1] * o[1]) + (o[2] * o[2] + o[3] * o[3]);
                    }
                q += __shfl_xor(q, 16); q += __shfl_xor(q, 32);
                if (fq == 0) P[(ai * 128 + wr * 64 + m * 16 + fr) * 4 + wc] = q;
                asm volatile("" ::: "memory");
            }
        asm volatile("s_waitcnt lgkmcnt(0)" ::: "memory"); __builtin_amdgcn_s_barrier(); asm volatile("" ::: "memory");
        const int rl = wid * 32 + (lane & 31);
        if (lane < 32) {
            const f32x4 p = *(const LAS f32x4*)(P + rl * 4);
            unsigned long long* sl = xslots + (size_t)(u.pm * 256 + rl) * 4;
            __hip_atomic_store(sl + u.pn, (1ull << 32) | (unsigned long long)__builtin_bit_cast(unsigned, (p[0] + p[1]) + (p[2] + p[3])), __ATOMIC_RELAXED, __HIP_MEMORY_SCOPE_AGENT);
            float s = 0.f;
#pragma unroll
            for (int t = 0; t < 4; ++t) {
                unsigned long long v = __hip_atomic_load(sl + t, __ATOMIC_RELAXED, __HIP_MEMORY_SCOPE_AGENT); unsigned spins = 0;
                while ((v >> 32) == 0ull && ++spins < (1u << 22)) { __builtin_amdgcn_s_sleep(1); v = __hip_atomic_load(sl + t, __ATOMIC_RELAXED, __HIP_MEMORY_SCOPE_AGENT); }
                s += __builtin_bit_cast(float, (unsigned)v);
            }
            Srs[rl] = 1.0f / sqrtf(s * (1.0f / D_) + EPS_);
        }
        asm volatile("s_waitcnt lgkmcnt(0)" ::: "memory"); __builtin_amdgcn_s_barrier(); asm volatile("" ::: "memory");
        f32x4 gv[2][2];
#pragma unroll
        for (int bj = 0; bj < 2; ++bj)
#pragma unroll
            for (int n = 0; n < 2; ++n) gv[bj][n] = *(const f32x4*)(gfin + col0 + bj * 128 + n * 16);
#pragma unroll
        for (int ai = 0; ai < 2; ++ai)
#pragma unroll
            for (int m = 0; m < 4; ++m) {
                const float rs = Srs[ai * 128 + wr * 64 + m * 16 + fr];
                const size_t rbase = (size_t)(row0 + ai * 128 + m * 16) * D_ + col0;
#pragma unroll
                for (int bj = 0; bj < 2; ++bj)
#pragma unroll
                    for (int n = 0; n < 2; ++n) *(f32x4*)(out + rbase + bj * 128 + n * 16) = acc[ai][bj][m][n] * rs * gv[bj][n];
            }
        asm volatile("s_waitcnt lgkmcnt(0)" ::: "memory"); __builtin_amdgcn_s_barrier(); asm volatile("" ::: "memory");
    }
};

__device__ __forceinline__ void p0_transpose_item(const float* W, int K, int N, bf16_t* WT, LAS float* scr, int item, int lane) {
    const int nblk = N / 32, kb = item / nblk, nb = item % nblk, k0 = 64 * kb, n0 = 32 * nb;
#pragma unroll 8
    for (int i = 0; i < 32; ++i) { const int kk = 2 * i + (lane >> 5); scr[kk * 33 + (lane & 31)] = W[(size_t)(k0 + kk) * N + n0 + (lane & 31)]; }
    asm volatile("s_waitcnt lgkmcnt(0)" ::: "memory");
    const int c = lane & 7;
#pragma unroll
    for (int j = 0; j < 4; ++j) { const int n = (lane >> 3) + 8 * j; const LAS float* s = scr + (8 * c) * 33 + n;
        u32x4 o; o.x = pk2(s[0 * 33], s[1 * 33]); o.y = pk2(s[2 * 33], s[3 * 33]); o.z = pk2(s[4 * 33], s[5 * 33]); o.w = pk2(s[6 * 33], s[7 * 33]);
        *(u32x4*)(WT + (size_t)(n0 + n) * K + k0 + 8 * c) = o; }
    asm volatile("s_waitcnt lgkmcnt(0)" ::: "memory");
}
__device__ __forceinline__ void p0_prologue(LAS unsigned char* lds, const float* x, const float* norm_in, const float* w_in, const float* w_pa, const float* w_pb, const float* w_out,
                                            bf16_t* WinT, bf16_t* WpaT, bf16_t* WpbT, bf16_t* WoutT, bf16_t* H, float* cosT, float* sinT) {
    const int tid = threadIdx.x, lane = tid & 63, wave = __builtin_amdgcn_readfirstlane(tid >> 6);
    LAS float* scr = (LAS float*)(lds + wave * 16384);
    const int gw = blockIdx.x * 8 + wave, NGW = gridDim.x * 8;
    constexpr int I_IN = (D_ / 64) * (NCOL_ / 32), I_SQ = (D_ / 64) * (D_ / 32);
    for (int it = gw; it < I_IN + 3 * I_SQ; it += NGW) {
        int r = it;
        if (r < I_IN) { p0_transpose_item(w_in, D_, NCOL_, WinT, scr, r, lane); continue; } r -= I_IN;
        if (r < I_SQ) { p0_transpose_item(w_pa, D_, D_, WpaT, scr, r, lane); continue; } r -= I_SQ;
        if (r < I_SQ) { p0_transpose_item(w_pb, D_, D_, WpbT, scr, r, lane); continue; } r -= I_SQ;
        p0_transpose_item(w_out, D_, D_, WoutT, scr, r, lane);
    }
    for (int idx = blockIdx.x * 512 + tid; idx < S_ * 128; idx += gridDim.x * 512) {
        const int s = idx >> 7, j = idx & 127;
        const float freq = exp2f(-(float)j * (1.0f / 128.0f) * 13.287712379549449f);
        const float ang = (float)s * freq;
        double rev = (double)ang * 0.15915494309189535; rev -= __builtin_rint(rev);
        const float r = (float)rev;
        cosT[idx] = __builtin_amdgcn_cosf(r); sinT[idx] = __builtin_amdgcn_sinf(r);
    }
    const f32x4* gp = (const f32x4*)norm_in + lane;
    f32x4 gv[4];
#pragma unroll
    for (int j = 0; j < 4; ++j) gv[j] = gp[64 * j];
    for (int m = gw; m < T_; m += 2 * NGW) {
        const f32x4* xr0 = (const f32x4*)(x + (size_t)m * D_) + lane; const f32x4* xr1 = (const f32x4*)(x + (size_t)(m + NGW) * D_) + lane;
        f32x4 v0[4], v1[4]; float ss0 = 0.f, ss1 = 0.f;
#pragma unroll
        for (int j = 0; j < 4; ++j) { v0[j] = __builtin_nontemporal_load(xr0 + 64 * j); v1[j] = __builtin_nontemporal_load(xr1 + 64 * j); }
#pragma unroll
        for (int j = 0; j < 4; ++j) { ss0 += (v0[j][0] * v0[j][0] + v0[j][1] * v0[j][1]) + (v0[j][2] * v0[j][2] + v0[j][3] * v0[j][3]);
                                      ss1 += (v1[j][0] * v1[j][0] + v1[j][1] * v1[j][1]) + (v1[j][2] * v1[j][2] + v1[j][3] * v1[j][3]); }
        const float rs0 = 1.0f / sqrtf(wave_sum(ss0) * (1.0f / D_) + EPS_), rs1 = 1.0f / sqrtf(wave_sum(ss1) * (1.0f / D_) + EPS_);
        u32x2* o0 = (u32x2*)(H + (size_t)m * D_) + lane; u32x2* o1 = (u32x2*)(H + (size_t)(m + NGW) * D_) + lane;
#pragma unroll
        for (int j = 0; j < 4; ++j) { u32x2 o; o.x = pk2(v0[j][0] * rs0 * gv[j][0], v0[j][1] * rs0 * gv[j][1]); o.y = pk2(v0[j][2] * rs0 * gv[j][2], v0[j][3] * rs0 * gv[j][3]); o0[64 * j] = o;
                                      u32x2 p; p.x = pk2(v1[j][0] * rs1 * gv[j][0], v1[j][1] * rs1 * gv[j][1]); p.y = pk2(v1[j][2] * rs1 * gv[j][2], v1[j][3] * rs1 * gv[j][3]); o1[64 * j] = p; }
    }
}

#define TR16(p) __builtin_amdgcn_ds_read_tr16_b64_v4i16((LAS s16x4*)(p))
#define MFMA16(a, b, c) __builtin_amdgcn_mfma_f32_16x16x32_bf16((a), (b), (c), 0, 0, 0)
__device__ __forceinline__ bf16x8 cat8(s16x4 a, s16x4 b) { return (bf16x8){a[0], a[1], a[2], a[3], b[0], b[1], b[2], b[3]}; }
__device__ __forceinline__ void ret_item(LAS unsigned char* lds, int item, const bf16_t* Qb, const bf16_t* Kb, const bf16_t* Vb, bf16_t* Oraw, f32x2* stats) {
    const int tid = threadIdx.x, w = __builtin_amdgcn_readfirstlane(tid >> 6), lane = tid & 63, n16 = lane & 15, g = lane >> 4, q4 = (lane & 15) >> 2, p4 = lane & 3;
    const int b = item >> 4, h = (item >> 2) & 3, es = item & 3;
    constexpr int KSB = 528, VSB = 144;
    LAS unsigned char* Ks = lds; LAS unsigned char* Vs = lds + 67584; LAS unsigned char* Rb = lds + 86016;
    const float lg = log2f(1.0f - exp2f(-5.0f - (float)h)); const float g128 = exp2f(128.0f * lg);
    f32x4 R[2][4];
#pragma unroll
    for (int a = 0; a < 2; ++a)
#pragma unroll
        for (int e = 0; e < 4; ++e) R[a][e] = (f32x4){0.f, 0.f, 0.f, 0.f};
    __syncthreads();
    for (int i = tid; i < 33792 / 16; i += 512) *(LAS u32x4*)(Rb + i * 16) = (u32x4){0u, 0u, 0u, 0u};
    const size_t rowbase = (size_t)b * S_;
    const bf16_t* Kg = Kb + rowbase * D_ + h * 256; const bf16_t* Vg = Vb + rowbase * D_ + h * 256 + es * 64; const bf16_t* Qg = Qb + rowbase * D_ + h * 256;
    u32x4 kreg[8], vreg[2];
#define RET_LOADKV(c) do { _Pragma("unroll") for (int i = 0; i < 8; ++i) { const int idx = tid + 512 * i; kreg[i] = *(const u32x4*)(Kg + (size_t)((c) * 128 + (idx >> 5)) * D_ + (idx & 31) * 8); } \
        _Pragma("unroll") for (int i = 0; i < 2; ++i) { const int idx = tid + 512 * i; vreg[i] = *(const u32x4*)(Vg + (size_t)((c) * 128 + (idx >> 3)) * D_ + (idx & 7) * 8); } } while (0)
    bf16x8 Qf[8];
#define RET_LOADQ(c) do { _Pragma("unroll") for (int ks = 0; ks < 8; ++ks) Qf[ks] = *(const bf16x8*)(Qg + (size_t)((c) * 128 + 16 * w + n16) * D_ + 32 * ks + 8 * g); } while (0)
    RET_LOADKV(0); RET_LOADQ(0);
    for (int c = 0; c < 16; ++c) {
#pragma unroll
        for (int i = 0; i < 8; ++i) { const int idx = tid + 512 * i; *(LAS u32x4*)(Ks + (idx >> 5) * KSB + (idx & 31) * 16) = kreg[i]; }
#pragma unroll
        for (int i = 0; i < 2; ++i) { const int idx = tid + 512 * i; *(LAS u32x4*)(Vs + (idx >> 3) * VSB + (idx & 7) * 16) = vreg[i]; }
        __syncthreads();
        f32x4 O[4];
#pragma unroll
        for (int et = 0; et < 4; ++et) O[et] = (f32x4){0.f, 0.f, 0.f, 0.f};
#pragma unroll
        for (int kk = 0; kk < 4; ++kk) if (2 * kk <= w) {
            f32x4 ST0 = (f32x4){0.f, 0.f, 0.f, 0.f}, ST1 = ST0;
#pragma unroll
            for (int ks = 0; ks < 8; ++ks) { const bf16x8 a = *(const LAS bf16x8*)(Ks + (32 * kk + n16) * KSB + (32 * ks + 8 * g) * 2); ST0 = MFMA16(a, Qf[ks], ST0); }
            if (2 * kk + 1 <= w) {
#pragma unroll
                for (int ks = 0; ks < 8; ++ks) { const bf16x8 a = *(const LAS bf16x8*)(Ks + (32 * kk + 16 + n16) * KSB + (32 * ks + 8 * g) * 2); ST1 = MFMA16(a, Qf[ks], ST1); }
            }
            if (2 * kk == w) {
#pragma unroll
                for (int r = 0; r < 4; ++r) if (4 * g + r > n16) ST0[r] = 0.f;
            }
            if (2 * kk + 1 == w) {
#pragma unroll
                for (int r = 0; r < 4; ++r) if (4 * g + r > n16) ST1[r] = 0.f;
            }
            bf16x8 pb;
            { const unsigned a0 = pk2(ST0[0], ST0[1]), a1 = pk2(ST0[2], ST0[3]), a2 = pk2(ST1[0], ST1[1]), a3 = pk2(ST1[2], ST1[3]);
              pb = __builtin_bit_cast(bf16x8, (u32x4){a0, a1, a2, a3}); }
#pragma unroll
            for (int et = 0; et < 4; ++et) {
                const s16x4 v0 = TR16(Vs + (32 * kk + 4 * g + q4) * VSB + (16 * et + 4 * p4) * 2);
                const s16x4 v1 = TR16(Vs + (32 * kk + 16 + 4 * g + q4) * VSB + (16 * et + 4 * p4) * 2);
                O[et] = MFMA16(cat8(v0, v1), pb, O[et]);
            }
        }
        if (c + 1 < 16) { RET_LOADKV(c + 1); }
#pragma unroll
        for (int ks = 0; ks < 8; ++ks)
#pragma unroll
            for (int et = 0; et < 4; ++et) { const bf16x8 a = *(const LAS bf16x8*)(Rb + (16 * et + n16) * KSB + (32 * ks + 8 * g) * 2); O[et] = MFMA16(a, Qf[ks], O[et]); }
        {
            const size_t tok = rowbase + c * 128 + 16 * w + n16; float s1 = 0.f, s2 = 0.f;
#pragma unroll
            for (int et = 0; et < 4; ++et) {
                const f32x4 o = O[et];
                s1 += (o[0] + o[1]) + (o[2] + o[3]); s2 += (o[0] * o[0] + o[1] * o[1]) + (o[2] * o[2] + o[3] * o[3]);
                u32x2 pkd; pkd.x = pk2(o[0], o[1]); pkd.y = pk2(o[2], o[3]);
                *(u32x2*)(Oraw + tok * D_ + h * 256 + es * 64 + 16 * et + 4 * g) = pkd;
            }
            s1 += __shfl_xor(s1, 16); s1 += __shfl_xor(s1, 32); s2 += __shfl_xor(s2, 16); s2 += __shfl_xor(s2, 32);
            if (g == 0) stats[(size_t)(es * 4 + h) * T_ + tok] = (f32x2){s1, s2};
        }
        if (c + 1 < 16) { RET_LOADQ(c + 1); }
#pragma unroll
        for (int a = 0; a < 2; ++a)
#pragma unroll
            for (int e = 0; e < 4; ++e) R[a][e] = R[a][e] * g128;
#pragma unroll 1
        for (int ks = 0; ks < 4; ++ks) {
            bf16x8 ka[2], vb[4];
#pragma unroll
            for (int dt = 0; dt < 2; ++dt) {
                const s16x4 t0 = TR16(Ks + (32 * ks + 8 * g + q4) * KSB + (32 * w + 16 * dt + 4 * p4) * 2);
                const s16x4 t1 = TR16(Ks + (32 * ks + 8 * g + 4 + q4) * KSB + (32 * w + 16 * dt + 4 * p4) * 2);
                ka[dt] = cat8(t0, t1);
            }
#pragma unroll
            for (int et = 0; et < 4; ++et) {
                const s16x4 t0 = TR16(Vs + (32 * ks + 8 * g + q4) * VSB + (16 * et + 4 * p4) * 2);
                const s16x4 t1 = TR16(Vs + (32 * ks + 8 * g + 4 + q4) * VSB + (16 * et + 4 * p4) * 2);
                vb[et] = cat8(t0, t1);
            }
#pragma unroll
            for (int dt = 0; dt < 2; ++dt)
#pragma unroll
                for (int et = 0; et < 4; ++et) R[dt][et] = MFMA16(ka[dt], vb[et], R[dt][et]);
        }
        __syncthreads();
#pragma unroll
        for (int dt = 0; dt < 2; ++dt)
#pragma unroll
            for (int et = 0; et < 4; ++et) { const f32x4 rs_ = R[dt][et] * g128; u32x2 pkd; pkd.x = pk2(rs_[0], rs_[1]); pkd.y = pk2(rs_[2], rs_[3]);
                *(LAS u32x2*)(Rb + (16 * et + n16) * KSB + (32 * w + 16 * dt + 4 * g) * 2) = pkd; }
    }
#undef RET_LOADKV
#undef RET_LOADQ
}


struct GnRow { u32x4 ov[2], gv[2]; f32x2 st[2][4]; };
__device__ __forceinline__ void gn_row_load(GnRow& R, const bf16_t* Oraw, const f32x2* stats, const bf16_t* GB, int row, int lane) {
#pragma unroll
    for (int half = 0; half < 2; ++half) {
        const int p = lane + 64 * half, hh = p >> 5; const size_t off = (size_t)row * D_ + p * 8;
        R.ov[half] = __builtin_nontemporal_load((const u32x4*)(Oraw + off)); R.gv[half] = __builtin_nontemporal_load((const u32x4*)(GB + off));
#pragma unroll
        for (int k = 0; k < 4; ++k) R.st[half][k] = stats[(size_t)(k * 4 + hh) * T_ + row];
    }
}
__device__ __forceinline__ void gn_row_finish(const GnRow& R, const f32x4 (&gnv)[2][2], bf16_t* GB, int row, int lane) {
#pragma unroll
    for (int half = 0; half < 2; ++half) {
        const int p = lane + 64 * half; const size_t off = (size_t)row * D_ + p * 8;
        const float mu = ((R.st[half][0][0] + R.st[half][1][0]) + (R.st[half][2][0] + R.st[half][3][0])) * (1.0f / 256.0f);
        const float var = ((R.st[half][0][1] + R.st[half][1][1]) + (R.st[half][2][1] + R.st[half][3][1])) * (1.0f / 256.0f) - mu * mu;
        const float rstd = 1.0f / sqrtf(fmaxf(var, 0.f) + EPS_);
        const u32x4 ov = R.ov[half], gv = R.gv[half];
        const f32x4 g0 = gnv[half][0], g1 = gnv[half][1];
        float gt[8] = {bf_lo(gv.x), bf_hi(gv.x), bf_lo(gv.y), bf_hi(gv.y), bf_lo(gv.z), bf_hi(gv.z), bf_lo(gv.w), bf_hi(gv.w)};
        const float oo[8] = {bf_lo(ov.x), bf_hi(ov.x), bf_lo(ov.y), bf_hi(ov.y), bf_lo(ov.z), bf_hi(ov.z), bf_lo(ov.w), bf_hi(ov.w)};
        const float gg[8] = {g0[0], g0[1], g0[2], g0[3], g1[0], g1[1], g1[2], g1[3]};
        float y[8];
#pragma unroll
        for (int q_ = 0; q_ < 8; ++q_) y[q_] = gt[q_] * sigm(gt[q_]) * ((oo[q_] - mu) * rstd * gg[q_]);
        u32x4 o; o.x = pk2(y[0], y[1]); o.y = pk2(y[2], y[3]); o.z = pk2(y[4], y[5]); o.w = pk2(y[6], y[7]);
        __builtin_nontemporal_store(o, (u32x4*)(GB + off));
    }
}
__device__ __forceinline__ void lru_item(LAS unsigned char* lds, int item, const bf16_t* XA, bf16_t* GY, const float* conv_w, const float* conv_b,
                                         const float* gxw, const float* gxb, const float* gaw, const float* gab, const float* lam,
                                         const bf16_t* Oraw, const f32x2* stats, const float* gain, bf16_t* GB, int gn_row0, int gn_stride) {
    const int tid = threadIdx.x, w = __builtin_amdgcn_readfirstlane(tid >> 6), lane = tid & 63, n16 = lane & 15, g = lane >> 4;
    const int b = item >> 4, n = item & 15;
    constexpr int XRB = 144, SGB = 128, XBB = 144, XS = 68;
    LAS unsigned char* XRw = lds + w * 2736; LAS unsigned char* SG = lds + 21888; LAS unsigned char* XCB = lds + 38272; LAS unsigned char* WX = lds + 56704; LAS unsigned char* WA = lds + 65920;
    LAS float* AF = (LAS float*)(lds + 75136); LAS float* UF = (LAS float*)(lds + 109952); LAS f32x2* SEG0 = (LAS f32x2*)(lds + 144768);
    LAS float* CW = (LAS float*)(lds + 152960); LAS float* CB = CW + 256; LAS float* BX = CW + 320; LAS float* BA = CW + 384; LAS float* SP = CW + 448;
    __syncthreads();
#pragma unroll
    for (int i = 0; i < 8; ++i) { const int idx = tid + 512 * i, k = idx >> 6, j = idx & 63;
        *(LAS bf16_t*)(WX + j * XBB + k * 2) = (bf16_t)f2bf(gxw[(size_t)n * 4096 + idx]);
        *(LAS bf16_t*)(WA + j * XBB + k * 2) = (bf16_t)f2bf(gaw[(size_t)n * 4096 + idx]); }
    if (tid < 256) CW[tid] = conv_w[(tid >> 6) * D_ + n * 64 + (tid & 63)];
    if (tid < 64) { CB[tid] = conv_b[n * 64 + tid]; BX[tid] = gxb[n * 64 + tid]; BA[tid] = gab[n * 64 + tid]; SP[tid] = log1pf(expf(-lam[n * 64 + tid])); }
    const int tl = tid >> 2, cgp = tid & 3;
    const bf16_t* xab = XA + (size_t)b * S_ * D_ + n * 64 + cgp * 16;
    bf16_t* gyb = GY + (size_t)b * S_ * D_ + n * 64;
    u32x4 xr0, xr1, sr0, sr1, hx0, hx1;
    const int hrow = lane >> 2;
#define LRU_LOAD(t0_) do { const u32x4* p_ = (const u32x4*)(xab + (size_t)((t0_) + tl) * D_); xr0 = __builtin_nontemporal_load(p_); xr1 = __builtin_nontemporal_load(p_ + 1); \
        const u32x4* q_ = (const u32x4*)(gyb + (size_t)((t0_) + tl) * D_ + cgp * 16); sr0 = __builtin_nontemporal_load(q_); sr1 = __builtin_nontemporal_load(q_ + 1); \
        hx0 = (u32x4){0u, 0u, 0u, 0u}; hx1 = hx0; \
        { const int th_ = (t0_) + 16 * w - 3 + hrow; if (lane < 12 && th_ >= 0) { const u32x4* h_ = (const u32x4*)(xab + (size_t)th_ * D_); hx0 = h_[0]; hx1 = h_[1]; } } } while (0)
#define LRU_STAGE() do { *(LAS u32x4*)(XRw + (3 + (lane >> 2)) * XRB + cgp * 32) = xr0; *(LAS u32x4*)(XRw + (3 + (lane >> 2)) * XRB + cgp * 32 + 16) = xr1; \
        if (lane < 12) { *(LAS u32x4*)(XRw + hrow * XRB + cgp * 32) = hx0; *(LAS u32x4*)(XRw + hrow * XRB + cgp * 32 + 16) = hx1; } \
        *(LAS u32x4*)(SG + tl * SGB + cgp * 32) = sr0; *(LAS u32x4*)(SG + tl * SGB + cgp * 32 + 16) = sr1; } while (0)
    LRU_LOAD(0); LRU_STAGE(); LRU_LOAD(128);
    __syncthreads();
    float state = 0.f;
    const int trow = 16 * w + n16;
    f32x4 gnv[2][2];
#pragma unroll
    for (int half = 0; half < 2; ++half) { gnv[half][0] = *(const f32x4*)(gain + (lane + 64 * half) * 8); gnv[half][1] = *(const f32x4*)(gain + (lane + 64 * half) * 8 + 4); }
    for (int tt = 0; tt < 16; ++tt) {
        const int t0 = tt * 128;
        GnRow gnr; gn_row_load(gnr, Oraw, stats, GB, gn_row0 + tt * gn_stride, lane);
        f32x4 xcv[4];
#pragma unroll
        for (int jt = 0; jt < 4; ++jt) {
            const int j0 = 16 * jt + 4 * g;
            f32x4 acc = *(const LAS f32x4*)(CB + j0);
#pragma unroll
            for (int k = 0; k < 4; ++k) {
                const f32x4 cwv = *(const LAS f32x4*)(CW + k * 64 + j0);
                const u32x2 raw = *(const LAS u32x2*)(XRw + (n16 + k) * XRB + j0 * 2);
                acc[0] += cwv[0] * bf_lo(raw.x); acc[1] += cwv[1] * bf_hi(raw.x); acc[2] += cwv[2] * bf_lo(raw.y); acc[3] += cwv[3] * bf_hi(raw.y);
            }
            xcv[jt] = acc;
            u32x2 pkd; pkd.x = pk2(acc[0], acc[1]); pkd.y = pk2(acc[2], acc[3]);
            *(LAS u32x2*)(XCB + trow * XBB + j0 * 2) = pkd;
        }
        __builtin_amdgcn_wave_barrier();
        {
            bf16x8 xb[2];
#pragma unroll
            for (int ks = 0; ks < 2; ++ks) xb[ks] = *(const LAS bf16x8*)(XCB + trow * XBB + (32 * ks + 8 * g) * 2);
#pragma unroll
            for (int jt = 0; jt < 4; ++jt) {
                f32x4 gx = (f32x4){0.f, 0.f, 0.f, 0.f}, ga = gx;
#pragma unroll
                for (int ks = 0; ks < 2; ++ks) {
                    const bf16x8 wxa = *(const LAS bf16x8*)(WX + (16 * jt + n16) * XBB + (32 * ks + 8 * g) * 2);
                    const bf16x8 waa = *(const LAS bf16x8*)(WA + (16 * jt + n16) * XBB + (32 * ks + 8 * g) * 2);
                    gx = MFMA16(wxa, xb[ks], gx); ga = MFMA16(waa, xb[ks], ga);
                }
                const int j0 = 16 * jt + 4 * g;
                const f32x4 bxv = *(const LAS f32x4*)(BX + j0), bav = *(const LAS f32x4*)(BA + j0), spv = *(const LAS f32x4*)(SP + j0);
                f32x4 av, uv;
#pragma unroll
                for (int r = 0; r < 4; ++r) {
                    const float it = sigm(gx[r] + bxv[r]), rt = sigm(ga[r] + bav[r]);
                    const float la = -8.0f * rt * spv[r];
                    const float aa = __expf(la);
                    av[r] = aa;
                    uv[r] = __builtin_amdgcn_sqrtf(fmaxf(1.0f - aa * aa, 0.f)) * (it * xcv[jt][r]);
                }
                *(LAS f32x4*)(AF + trow * XS + j0) = av; *(LAS f32x4*)(UF + trow * XS + j0) = uv;
            }
        }
        __builtin_amdgcn_wave_barrier();
        float hl[16], ac[16], sg[16];
        {
            float hh = 0.f, aa = 1.f;
#pragma unroll
            for (int s = 0; s < 16; ++s) { const float a = AF[(16 * w + s) * XS + lane], u = UF[(16 * w + s) * XS + lane]; hh = a * hh + u; aa *= a; hl[s] = hh; ac[s] = aa; }
            SEG0[(tt & 1) * 512 + w * 64 + lane] = (f32x2){aa, hh};
#pragma unroll
            for (int s = 0; s < 16; ++s) { const float gv_ = bf1(*(const LAS bf16_t*)(SG + (16 * w + s) * SGB + lane * 2)); sg[s] = gv_ * sigm(gv_); }
        }
        __syncthreads();
        if (tt + 1 < 16) { LRU_STAGE(); if (tt + 2 < 16) LRU_LOAD(t0 + 256); }
        float hin = 0.f;
        {
            float hc = state;
#pragma unroll
            for (int s2 = 0; s2 < 8; ++s2) { if (s2 == w) hin = hc; const f32x2 sv = SEG0[(tt & 1) * 512 + s2 * 64 + lane]; hc = sv.x * hc + sv.y; }
            state = hc;
        }
#pragma unroll
        for (int s = 0; s < 16; ++s) { const float ht = hl[s] + ac[s] * hin; gyb[(size_t)(t0 + 16 * w + s) * D_ + lane] = (bf16_t)f2bf(sg[s] * ht); }
        gn_row_finish(gnr, gnv, GB, gn_row0 + tt * gn_stride, lane);
        __builtin_amdgcn_wave_barrier();
    }
#undef LRU_LOAD
#undef LRU_STAGE
}

#define XB_TMO      128
#define XB_XCNT(j)  (256  + 64 * (j))
#define XB_XSUB(j)  (1280 + 64 * (j))
#define XB_XGEN(j)  (2304 + 64 * (j))
#define XB_TOP      3328
#define XB_TOPGEN   3392
#define XCD_BAR_WORDS 3456
#define XB_SPIN_CAP (1u << 18)

__device__ __forceinline__ unsigned xb_ld(unsigned* p)              { return __hip_atomic_load(p, __ATOMIC_RELAXED, __HIP_MEMORY_SCOPE_AGENT); }
__device__ __forceinline__ unsigned xb_add(unsigned* p, unsigned v) { return __hip_atomic_fetch_add(p, v, __ATOMIC_RELAXED, __HIP_MEMORY_SCOPE_AGENT); }
__device__ __forceinline__ unsigned xb_xcc_id() { return (unsigned)__builtin_amdgcn_s_getreg((3 << 11) | 20) & 0xFu; }
#define XB_SPIN(cond, bar) do { unsigned _sp = 0; while (cond) { __builtin_amdgcn_s_sleep(1); \
    if ((++_sp & 255u) == 0u) { if (xb_ld(&(bar)[XB_TMO])) break; if (_sp > XB_SPIN_CAP) { atomicAdd(&(bar)[XB_TMO], 1u); break; } } } } while (0)

struct XcdBarrier {
    unsigned* bar; unsigned x;
    volatile LAS unsigned* st;
};

__device__ __forceinline__ XcdBarrier xcd_barrier_post(unsigned* bar, volatile LAS unsigned* st) {
    XcdBarrier b; b.bar = bar; b.x = xb_xcc_id(); b.st = st;
    if (threadIdx.x == 0) (void)xb_add(&bar[XB_XCNT(b.x)], 1u);
    return b;
}
__device__ __forceinline__ void xcd_barrier_complete(unsigned* bar, unsigned x, unsigned& nloc, unsigned& nx) {
    const unsigned G = gridDim.x * gridDim.y * gridDim.z;
    unsigned sum, cnt, mine, sp = 0u;
    for (;;) {
        sum = 0u; cnt = 0u; mine = 0u;
#pragma unroll
        for (unsigned j = 0; j < 16; ++j) { const unsigned c = xb_ld(&bar[XB_XCNT(j)]); sum += c; cnt += (c > 0u) ? 1u : 0u; mine = (j == x) ? c : mine; }
        if (sum == G) break;
        __builtin_amdgcn_s_sleep(1);
        if ((++sp & 255u) == 0u) { if (xb_ld(&bar[XB_TMO])) break; if (sp > XB_SPIN_CAP) { atomicAdd(&bar[XB_TMO], 1u); break; } }
    }
    nloc = mine > 0u ? mine : 1u; nx = cnt > 0u ? cnt : 1u;
}

__device__ __forceinline__ void xcd_barrier(const XcdBarrier& b) {
    asm volatile("s_waitcnt vmcnt(0)" ::: "memory");
    __syncthreads();
    if (threadIdx.x == 0) {
        unsigned* bar = b.bar;
        __builtin_amdgcn_s_waitcnt(0);
        unsigned nloc = b.st[0], nx = b.st[1];
        if (nloc == 0u) { xcd_barrier_complete(bar, b.x, nloc, nx); b.st[0] = nloc; b.st[1] = nx; }
        const unsigned old = xb_add(&bar[XB_XSUB(b.x)], 1u);
        const unsigned gen = old / nloc;
        if (old + 1u == (gen + 1u) * nloc) {
            __builtin_amdgcn_fence(__ATOMIC_RELEASE, "agent");
            asm volatile("s_waitcnt vmcnt(0)" ::: "memory");
            const unsigned og = xb_add(&bar[XB_TOP], 1u);
            const unsigned tg = og / nx;
            if (og + 1u == (tg + 1u) * nx) xb_add(&bar[XB_TOPGEN], 1u);
            else XB_SPIN(xb_ld(&bar[XB_TOPGEN]) == tg, bar);
            __builtin_amdgcn_fence(__ATOMIC_ACQUIRE, "agent");
            xb_add(&bar[XB_XGEN(b.x)], 1u);
            asm volatile("s_waitcnt vmcnt(0)" ::: "memory");
        } else {
            XB_SPIN(xb_ld(&bar[XB_XGEN(b.x)]) == gen, bar);
            __builtin_amdgcn_fence(__ATOMIC_ACQUIRE, "agent");
            asm volatile("s_waitcnt vmcnt(0)" ::: "memory");
        }
    }
    __syncthreads();
}

struct Args { const float* in[15]; float* out; unsigned char* ws; int never, pad; };
__global__ void __launch_bounds__(512) mega_fwd(Args a) {
    extern __shared__ __attribute__((aligned(16))) unsigned char lds_raw[];
    LAS unsigned char* lds = (LAS unsigned char*)lds_raw;
    cg::grid_group grid = cg::this_grid();
#define SEAM() xcd_barrier(xbar)
#define RUN(k) if (a.never != 100 + (k))
    unsigned char* ws = a.ws;
    bf16_t* WinT = (bf16_t*)(ws + WS_WIN); bf16_t* WpaT = (bf16_t*)(ws + WS_WPA); bf16_t* WpbT = (bf16_t*)(ws + WS_WPB); bf16_t* WoutT = (bf16_t*)(ws + WS_WOUT);
    float* cosT = (float*)(ws + WS_COS); float* sinT = (float*)(ws + WS_SIN); f32x2* stats = (f32x2*)(ws + WS_STAT);
    bf16_t* seg0 = (bf16_t*)(ws + WS_SEG0);
    bf16_t* XA = seg0; bf16_t* GY = seg0 + SEG_ELEMS; bf16_t* Qb = seg0 + 2 * SEG_ELEMS; bf16_t* Kb = seg0 + 3 * SEG_ELEMS; bf16_t* Vb = seg0 + 4 * SEG_ELEMS;
    bf16_t* GB = seg0 + 5 * SEG_ELEMS; bf16_t* MA = seg0 + 6 * SEG_ELEMS; bf16_t* MRG = seg0;
    bf16_t* H = (bf16_t*)a.out; bf16_t* Oraw = (bf16_t*)a.out; bf16_t* MB = (bf16_t*)a.out + SEG_ELEMS;
    const int G = gridDim.x;
    volatile LAS unsigned* xst = (volatile LAS unsigned*)(lds + LDS_BYTES - 64);
    if (threadIdx.x < 2) xst[threadIdx.x] = 0u;
    __syncthreads();
    const XcdBarrier xbar = xcd_barrier_post((unsigned*)(ws + WS_CTL), xst);

    RUN(0) p0_prologue(lds, a.in[0], a.in[1], a.in[2], a.in[11], a.in[12], a.in[13], WinT, WpaT, WpbT, WoutT, H, cosT, sinT);
    SEAM();
    RUN(1) {
        pg8::Gemm gm{H, WinT, T_, NCOL_, D_}; pg8::StaticOrder S; S.init(T_, NCOL_, G, (int)blockIdx.x);
        EpiProj E{seg0, MB, cosT, sinT};
        pg8::gemm_phase<EpiProj, pg8::StaticOrder, true, true>(lds, gm, S, E);
    }
    SEAM();
    RUN(2) for (int it = blockIdx.x; it < 256; it += G) { const int xcd = it & 7, slot = it >> 3; ret_item(lds, (((slot >> 2) * 8 + xcd) << 2) | (slot & 3), Qb, Kb, Vb, Oraw, stats); }
    SEAM();
    RUN(3) lru_item(lds, (int)blockIdx.x, XA, GY, a.in[3], a.in[4], a.in[5], a.in[6], a.in[7], a.in[8], a.in[9], Oraw, stats, a.in[10], GB, (int)blockIdx.x * 8 + (int)(threadIdx.x >> 6), G * 8);
    SEAM();
    RUN(4) {
    __syncthreads();
    { pg8::Gemm gm{GY, WpaT, T_, D_, D_}; pg8::StaticOrder S; S.init(T_, D_, G, (int)blockIdx.x); EpiGate<0> E{MA, MRG};
      pg8::gemm_phase<EpiGate<0>, pg8::StaticOrder, true, true>(lds, gm, S, E); }
    { pg8::Gemm gm{GB, WpbT, T_, D_, D_}; pg8::StaticOrder S; S.init(T_, D_, G, (int)blockIdx.x); EpiGate<1> E{MB, MRG};
      pg8::gemm_phase<EpiGate<1>, pg8::StaticOrder, true, true>(lds, gm, S, E); }
    }
    SEAM();
#define OUT_HALF(r) do { const size_t roff = (size_t)(r) * 16384 * D_; \
        pg8::Gemm gm{MRG + roff, WoutT, 16384, D_, D_}; pg8::StaticOrder S; S.init(16384, D_, G, (int)blockIdx.x); \
        EpiResidNorm E{a.in[0] + roff, a.out + roff, a.in[14], (unsigned long long*)(ws + WS_XSLOT) + (size_t)(r) * 16384 * 4}; \
        pg8::gemm_phase<EpiResidNorm, pg8::StaticOrder, false, true>(lds, gm, S, E); } while (0)
    RUN(5) { OUT_HALF(0); OUT_HALF(1); }
#undef OUT_HALF
    if (a.never == 0x7fffffff) grid.sync();
#undef SEAM
#undef RUN
}

extern "C" void kernel_launch(void* const* d_in, const int* in_sizes, int n_in, void* d_out, int out_size, void* d_ws, size_t ws_size, hipStream_t stream) {
    static int ready = 0;
    if (ready == 0) {
        ready = 1;
        if (n_in != 15 || out_size != T_ * D_ || ws_size < WS_END) { fprintf(stderr, "kernel_launch: built for 15 inputs, %d outputs, >= %zu B of workspace (got %d, %d, %zu)\n", T_ * D_, (size_t)WS_END, n_in, out_size, ws_size); ready = -1; }
        else if (hipFuncSetAttribute((const void*)mega_fwd, hipFuncAttributeMaxDynamicSharedMemorySize, LDS_BYTES) != hipSuccess) { fprintf(stderr, "kernel_launch: hipFuncSetAttribute failed\n"); ready = -1; }
    }
    if (ready < 0) return;
    if (hipMemsetAsync((char*)d_ws + WS_CTL, 0, CTL_BYTES, stream) != hipSuccess) { fprintf(stderr, "kernel_launch: hipMemsetAsync failed\n"); return; }
    Args a{};
    for (int i = 0; i < 15; ++i) a.in[i] = (const float*)d_in[i];
    a.out = (float*)d_out; a.ws = (unsigned char*)d_ws;
    void* args[] = {&a};
    hipError_t e = hipLaunchCooperativeKernel((const void*)mega_fwd, dim3(256), dim3(512), args, LDS_BYTES, stream);
    if (e != hipSuccess) fprintf(stderr, "cooperative launch failed: %s\n", hipGetErrorString(e));
}
```
